# Optimizing an MI355X kernel written in HIP

```python
import jax, jax.numpy as jnp
from jax import lax
import numpy as np

D_MODEL = 1024
BATCH = 2
SEQ = 8192
DEPTH = 1

HEAD_DIM = 64
GRID_W = 64
NA_HEADS = 8
NA_KH_MAX = 8
NA_KW = 16
NA_QCB = NA_KW
NA_SPAN = 2 * NA_KW
SW_HEADS = 8
SW_KV_HEADS = 2
SW_WINDOW = 128
SW_BLOCK = 128
T5_BUCKETS = 32
T5_MAX_DIST = 128
FFN_HIDDEN = -(-8 * D_MODEL // (3 * 256)) * 256

A_W = NA_HEADS * HEAD_DIM
B_QW = SW_HEADS * HEAD_DIM
B_KVW = SW_KV_HEADS * HEAD_DIM
IN_WIDTHS = [A_W, A_W, A_W, B_QW, B_KVW, B_KVW, D_MODEL, D_MODEL]
IN_WIDTH = sum(IN_WIDTHS)
IN_SPLITS = list(np.cumsum(IN_WIDTHS)[:-1])
RMS_EPS = 1e-6
NEG_INF = -1e30

kernel_name = "hybrid_natten_swa_gated_encoder_block"


def rms_norm(x, g):
    xf = x.astype(jnp.float32)
    y = xf * lax.rsqrt(jnp.mean(xf * xf, axis=-1, keepdims=True) + RMS_EPS)
    return y.astype(x.dtype) * g


def t5_bucket(rel):
    half = T5_BUCKETS // 2
    max_exact = half // 2
    ret = (rel > 0).astype(np.int32) * half
    n = np.abs(rel)
    large = max_exact + (np.log(np.maximum(n, 1) / max_exact)
                         / np.log(T5_MAX_DIST / max_exact) * (half - max_exact)).astype(np.int32)
    large = np.minimum(large, half - 1)
    return ret + np.where(n < max_exact, n, large)


def neighbourhood_attention(q, k, v, rpb):
    B, T, H, D = q.shape
    rows = T // GRID_W
    kh = min(NA_KH_MAX, rows)
    ncb = GRID_W // NA_QCB
    r = np.arange(rows)
    row_start = np.clip(r - kh // 2, 0, rows - kh)
    key_rows = row_start[:, None] + np.arange(kh)[None, :]
    j = np.arange(ncb)
    span_start = np.clip(j * NA_QCB - NA_KW // 2, 0, GRID_W - NA_SPAN)
    key_cols = span_start[:, None] + np.arange(NA_SPAN)[None, :]
    q_cols = j[:, None] * NA_QCB + np.arange(NA_QCB)[None, :]
    win_start = np.clip(q_cols - NA_KW // 2, 0, GRID_W - NA_KW)
    kc = key_cols[:, None, :]
    in_win = (kc >= win_start[..., None]) & (kc < win_start[..., None] + NA_KW)

    idx = (key_rows[:, None, :, None] * GRID_W + key_cols[None, :, None, :]).reshape(rows, ncb, kh * NA_SPAN)
    kg = jnp.take(k, idx, axis=1)
    vg = jnp.take(v, idx, axis=1)
    qb = q.reshape(B, rows, ncb, NA_QCB, H, D)
    s = jnp.einsum('brjqhd,brjkhd->brjhqk', qb, kg,
                   preferred_element_type=jnp.float32) * (HEAD_DIM ** -0.5)

    dr = key_rows - r[:, None] + (NA_KH_MAX - 1)
    dc = np.clip(kc - q_cols[..., None], -(NA_KW - 1), NA_KW - 1) + (NA_KW - 1)
    bias = rpb[dr[:, None, None, :, None], dc[None, :, :, None, :]]
    bias = jnp.transpose(bias, (0, 1, 5, 2, 3, 4)).astype(jnp.float32)
    bias = jnp.where(in_win[None, :, None, :, None, :], bias, NEG_INF)
    bias = bias.reshape(rows, ncb, H, NA_QCB, kh * NA_SPAN)
    p = jax.nn.softmax(s + bias[None], axis=-1)
    o = jnp.einsum('brjhqk,brjkhd->brjqhd', p.astype(v.dtype), vg)
    return o.reshape(B, T, H, D)


def sliding_window_attention(q, k, v, sink, t5_table):
    B, T, H, D = q.shape
    kvh = k.shape[2]
    g = H // kvh
    nb = T // SW_BLOCK
    pad = ((0, 0), (SW_BLOCK, SW_BLOCK), (0, 0), (0, 0))
    kp = jnp.pad(k, pad).reshape(B, nb + 2, SW_BLOCK, kvh, D)
    vp = jnp.pad(v, pad).reshape(B, nb + 2, SW_BLOCK, kvh, D)
    kw = jnp.concatenate([kp[:, :-2], kp[:, 1:-1], kp[:, 2:]], axis=2)
    vw = jnp.concatenate([vp[:, :-2], vp[:, 1:-1], vp[:, 2:]], axis=2)
    qb = q.reshape(B, nb, SW_BLOCK, kvh, g, D)
    s = jnp.einsum('bnqkgd,bnskd->bnkgqs', qb, kw,
                   preferred_element_type=jnp.float32) * (HEAD_DIM ** -0.5)

    rel = np.arange(3 * SW_BLOCK)[None, :] - SW_BLOCK - np.arange(SW_BLOCK)[:, None]
    bias = t5_table[t5_bucket(rel)]
    bias = jnp.transpose(bias, (2, 0, 1)).reshape(kvh, g, SW_BLOCK, 3 * SW_BLOCK).astype(jnp.float32)
    key_pos = np.arange(nb)[:, None] * SW_BLOCK + np.arange(3 * SW_BLOCK)[None, :] - SW_BLOCK
    valid = (np.abs(rel) <= SW_WINDOW)[None] & ((key_pos >= 0) & (key_pos < T))[:, None, :]
    s = jnp.where(valid[None, :, None, None], s + bias[None, None], NEG_INF)

    sk = sink.astype(jnp.float32).reshape(1, 1, kvh, g, 1, 1)
    m = jnp.maximum(jnp.max(s, axis=-1, keepdims=True), sk)
    e = jnp.exp(s - m)
    p = e / (jnp.sum(e, axis=-1, keepdims=True) + jnp.exp(sk - m))
    o = jnp.einsum('bnkgqs,bnskd->bnqkgd', p.astype(v.dtype), vw)
    return o.reshape(B, T, H, D)


def setup_inputs(seed: int = 0) -> dict:
    key = jax.random.key(seed)
    ks = jax.random.split(key, 18)
    f32 = jnp.float32

    def w(k, shape, fan_in):
        return jax.random.normal(k, shape, f32) * fan_in ** -0.5

    def gain(k, shape):
        return 1.0 + 0.05 * jax.random.normal(k, shape, f32)

    return {
        "x": jax.random.normal(ks[0], (BATCH, SEQ, D_MODEL), f32),
        "norm_mix": gain(ks[1], (DEPTH, D_MODEL)),
        "w_in": w(ks[2], (DEPTH, D_MODEL, IN_WIDTH), D_MODEL),
        "q_norm_a": gain(ks[3], (DEPTH, HEAD_DIM)),
        "k_norm_a": gain(ks[4], (DEPTH, HEAD_DIM)),
        "rpb_a": 0.1 * jax.random.normal(ks[5], (DEPTH, 2 * NA_KH_MAX - 1, 2 * NA_KW - 1, NA_HEADS), f32),
        "q_norm_b": gain(ks[6], (DEPTH, HEAD_DIM)),
        "k_norm_b": gain(ks[7], (DEPTH, HEAD_DIM)),
        "sink_b": 1.0 + 0.5 * jax.random.normal(ks[8], (DEPTH, SW_HEADS), f32),
        "t5_table": 0.1 * jax.random.normal(ks[9], (T5_BUCKETS, SW_HEADS), f32),
        "w_branch_a": w(ks[10], (DEPTH, A_W, D_MODEL), A_W),
        "w_branch_b": w(ks[11], (DEPTH, B_QW, D_MODEL), B_QW),
        "w_out": w(ks[12], (DEPTH, D_MODEL, D_MODEL), D_MODEL),
        "norm_ffn": gain(ks[13], (DEPTH, D_MODEL)),
        "w_gate": w(ks[14], (DEPTH, D_MODEL, FFN_HIDDEN), D_MODEL),
        "w_up": w(ks[15], (DEPTH, D_MODEL, FFN_HIDDEN), D_MODEL),
        "w_down": w(ks[16], (DEPTH, FFN_HIDDEN, D_MODEL), FFN_HIDDEN),
    }


def reference(x, norm_mix, w_in, q_norm_a, k_norm_a, rpb_a, q_norm_b, k_norm_b, sink_b,
              t5_table, w_branch_a, w_branch_b, w_out, norm_ffn, w_gate, w_up, w_down):
    B, T, _ = x.shape
    for l in range(DEPTH):
        h = rms_norm(x, norm_mix[l])
        proj = jnp.einsum('btd,de->bte', h, w_in[l])
        q_a, k_a, v_a, q_b, k_b, v_b, g_a, g_b = jnp.split(proj, IN_SPLITS, axis=-1)

        q_a = rms_norm(q_a.reshape(B, T, NA_HEADS, HEAD_DIM), q_norm_a[l])
        k_a = rms_norm(k_a.reshape(B, T, NA_HEADS, HEAD_DIM), k_norm_a[l])
        v_a = v_a.reshape(B, T, NA_HEADS, HEAD_DIM)
        o_a = neighbourhood_attention(q_a, k_a, v_a, rpb_a[l]).reshape(B, T, A_W)

        q_b = rms_norm(q_b.reshape(B, T, SW_HEADS, HEAD_DIM), q_norm_b[l])
        k_b = rms_norm(k_b.reshape(B, T, SW_KV_HEADS, HEAD_DIM), k_norm_b[l])
        v_b = v_b.reshape(B, T, SW_KV_HEADS, HEAD_DIM)
        o_b = sliding_window_attention(q_b, k_b, v_b, sink_b[l], t5_table).reshape(B, T, B_QW)

        y = (jax.nn.sigmoid(g_a) * jnp.einsum('bte,ed->btd', o_a, w_branch_a[l])
             + jax.nn.sigmoid(g_b) * jnp.einsum('bte,ed->btd', o_b, w_branch_b[l]))
        x = x + jnp.einsum('btd,de->bte', y, w_out[l])

        h = rms_norm(x, norm_ffn[l])
        u = jax.nn.silu(jnp.einsum('btd,df->btf', h, w_gate[l])) * jnp.einsum('btd,df->btf', h, w_up[l])
        x = x + jnp.einsum('btf,fd->btd', u, w_down[l])
    return x
```

```cpp
#include <hip/hip_runtime.h>
#include <cstdio>
#include <cstdint>
#include <hip/hip_runtime.h>
#include <cstdint>
#include <cstddef>
namespace nv {
typedef unsigned short bf16;
__device__ __forceinline__ float bf2f(bf16 v) { return __uint_as_float(((unsigned)v) << 16); }
__device__ __forceinline__ bf16 f2bf(float f) { unsigned u = __float_as_uint(f); return (bf16)((u + 0x7fffu + ((u >> 16) & 1u)) >> 16); }

constexpr int B_ = 2, T_ = 8192, D_ = 1024, M_ = B_ * T_, FF_ = 2816, NIN_ = 4352;

__global__ void k_rowscale(const float* __restrict__ x, float* __restrict__ rs) {
    const int gw = (blockIdx.x * blockDim.x + threadIdx.x) >> 6, lane = threadIdx.x & 63;
    if (gw >= M_) return;
    const float* r = x + (size_t)gw * D_;
    float s = 0.f;
    for (int i = lane; i < D_; i += 64) { const float v = r[i]; s += v * v; }
    for (int o = 1; o < 64; o <<= 1) s += __shfl_xor(s, o);
    if (lane == 0) rs[gw] = rsqrtf(s * (1.0f / D_) + 1e-6f);
}
__global__ void k_rowss(const float* __restrict__ x, float* __restrict__ ss) {
    const int gw = (blockIdx.x * blockDim.x + threadIdx.x) >> 6, lane = threadIdx.x & 63;
    if (gw >= M_) return;
    const float* r = x + (size_t)gw * D_;
    float s = 0.f;
    for (int i = lane; i < D_; i += 64) { const float v = r[i]; s += v * v; }
    for (int o = 1; o < 64; o <<= 1) s += __shfl_xor(s, o);
    if (lane < 4) ss[(size_t)gw * 4 + lane] = lane == 0 ? s : 0.f;
}

template <class LA>
__device__ __forceinline__ void tile_gemm(float (&acc)[4][4], LA la, const float* __restrict__ Bm, int ldb, int K, int m0, int n0, float* As, float* Bs) {
    const int tid = threadIdx.x, tx = tid & 15, ty = tid >> 4;
#pragma unroll
    for (int i = 0; i < 4; ++i)
#pragma unroll
        for (int j = 0; j < 4; ++j) acc[i][j] = 0.f;
    for (int k0 = 0; k0 < K; k0 += 16) {
#pragma unroll
        for (int i = 0; i < 4; ++i) { const int e = tid + i * 256, r = e >> 4, kk = e & 15; As[kk * 65 + r] = la(m0 + r, k0 + kk); }
#pragma unroll
        for (int i = 0; i < 4; ++i) { const int e = tid + i * 256, kk = e >> 6, c = e & 63; Bs[kk * 64 + c] = Bm[(size_t)(k0 + kk) * ldb + n0 + c]; }
        __syncthreads();
#pragma unroll
        for (int kk = 0; kk < 16; ++kk) {
            float a[4], b[4];
#pragma unroll
            for (int i = 0; i < 4; ++i) a[i] = As[kk * 65 + ty * 4 + i];
#pragma unroll
            for (int j = 0; j < 4; ++j) b[j] = Bs[kk * 64 + tx * 4 + j];
#pragma unroll
            for (int i = 0; i < 4; ++i)
#pragma unroll
                for (int j = 0; j < 4; ++j) acc[i][j] = fmaf(a[i], b[j], acc[i][j]);
        }
        __syncthreads();
    }
}

struct Bufs {
    bf16 *QA, *KA, *VAT, *QB, *KB, *VB, *GATE, *OA, *OB, *Y, *X1B, *U;
    float *RS1, *SS;
};

__global__ void __launch_bounds__(256) k_inproj(const float* __restrict__ x, const float* __restrict__ g1, const float* __restrict__ rs1, const float* __restrict__ w_in,
                                                const float* __restrict__ qna, const float* __restrict__ kna, const float* __restrict__ qnb, const float* __restrict__ knb, Bufs b) {
    __shared__ float As[16 * 65], Bs[16 * 64], red[64 * 17];
    const int n0 = blockIdx.x * 64, m0 = blockIdx.y * 64, tid = threadIdx.x, tx = tid & 15, ty = tid >> 4;
    float acc[4][4];
    tile_gemm(acc, [&](int m, int k) { return x[(size_t)m * D_ + k] * g1[k]; }, w_in, NIN_, D_, m0, n0, As, Bs);
#pragma unroll
    for (int i = 0; i < 4; ++i) { const float r = rs1[m0 + ty * 4 + i];
#pragma unroll
        for (int j = 0; j < 4; ++j) acc[i][j] *= r; }
    const float* gn = nullptr;
    if (n0 < 512) gn = qna; else if (n0 < 1024) gn = kna; else if (n0 >= 1536 && n0 < 2048) gn = qnb; else if (n0 >= 2048 && n0 < 2176) gn = knb;
    if (gn) {
#pragma unroll
        for (int i = 0; i < 4; ++i) { float s = 0.f;
#pragma unroll
            for (int j = 0; j < 4; ++j) s += acc[i][j] * acc[i][j];
            red[(ty * 4 + i) * 17 + tx] = s; }
        __syncthreads();
#pragma unroll
        for (int i = 0; i < 4; ++i) { float s = 0.f;
            for (int t = 0; t < 16; ++t) s += red[(ty * 4 + i) * 17 + t];
            const float r = rsqrtf(s * (1.0f / 64.0f) + 1e-6f);
#pragma unroll
            for (int j = 0; j < 4; ++j) acc[i][j] = acc[i][j] * r * gn[tx * 4 + j]; }
    }
#pragma unroll
    for (int i = 0; i < 4; ++i) { const int m = m0 + ty * 4 + i;
#pragma unroll
        for (int j = 0; j < 4; ++j) { const int n = n0 + tx * 4 + j; const float v = acc[i][j];
            if (n < 512) b.QA[(size_t)m * 512 + n] = f2bf(v);
            else if (n < 1024) b.KA[(size_t)m * 512 + (n - 512)] = f2bf(v);
            else if (n < 1536) { const int c = n - 1024, h = c >> 6, d = c & 63, bb = m / T_, t = m % T_; b.VAT[((size_t)(bb * 8 + h) * 64 + d) * T_ + t] = f2bf(v); }
            else if (n < 2048) b.QB[(size_t)m * 512 + (n - 1536)] = f2bf(v);
            else if (n < 2176) b.KB[(size_t)m * 128 + (n - 2048)] = f2bf(v);
            else if (n < 2304) b.VB[(size_t)m * 128 + (n - 2176)] = f2bf(v);
            else b.GATE[(size_t)m * 2048 + (n - 2304)] = f2bf(1.0f / (1.0f + expf(-v))); } }
}

__global__ void __launch_bounds__(256) k_natten(const float* __restrict__ rpb, Bufs b) {
    const int gid = blockIdx.x * 256 + threadIdx.x; if (gid >= M_ * 8) return;
    const int h = gid & 7, m = gid >> 3, bb = m / T_, t = m % T_, r = t >> 6, qc = t & 63;
    int rs = r - 4; rs = rs < 0 ? 0 : (rs > 120 ? 120 : rs);
    int ws = qc - 8; ws = ws < 0 ? 0 : (ws > 48 ? 48 : ws);
    float q[64], o[64];
#pragma unroll
    for (int d = 0; d < 64; ++d) { q[d] = bf2f(b.QA[(size_t)m * 512 + h * 64 + d]); o[d] = 0.f; }
    float mx = -3.0e38f, l = 0.f;
    for (int kr = 0; kr < 8; ++kr)
        for (int kc = 0; kc < 16; ++kc) {
            const int krow = rs + kr, kcol = ws + kc, tk = krow * 64 + kcol; const size_t mk = (size_t)bb * T_ + tk;
            float s = 0.f;
#pragma unroll
            for (int d = 0; d < 64; ++d) s = fmaf(q[d], bf2f(b.KA[mk * 512 + h * 64 + d]), s);
            const int dr = krow - r + 7, dc = kcol - qc + 15;
            s = s * 0.125f + rpb[(dr * 31 + dc) * 8 + h];
            const float mn = fmaxf(mx, s), f = __expf(mx - mn), p = __expf(s - mn);
            l = l * f + p; mx = mn;
#pragma unroll
            for (int d = 0; d < 64; ++d) o[d] = o[d] * f + p * bf2f(b.VAT[((size_t)(bb * 8 + h) * 64 + d) * T_ + tk]);
        }
    const float il = 1.0f / l;
#pragma unroll
    for (int d = 0; d < 64; ++d) b.OA[(size_t)m * 512 + h * 64 + d] = f2bf(o[d] * il);
}

__device__ __forceinline__ int t5_bucket(int rel) {
    const int n = rel < 0 ? -rel : rel;
    const int large = 8 + (n >= 12) + (n >= 16) + (n >= 23) + (n >= 32) + (n >= 46) + (n >= 64) + (n >= 91);
    return (rel > 0 ? 16 : 0) + (n < 8 ? n : large);
}
__global__ void __launch_bounds__(256) k_swa(const float* __restrict__ sink, const float* __restrict__ t5, Bufs b) {
    const int gid = blockIdx.x * 256 + threadIdx.x; if (gid >= M_ * 8) return;
    const int h = gid & 7, m = gid >> 3, bb = m / T_, t = m % T_, kvh = h >> 2;
    float q[64], o[64];
#pragma unroll
    for (int d = 0; d < 64; ++d) { q[d] = bf2f(b.QB[(size_t)m * 512 + h * 64 + d]); o[d] = 0.f; }
    float mx = sink[h], l = 1.0f;
    const int lo = t - 128 < 0 ? 0 : t - 128, hi = t + 128 > T_ - 1 ? T_ - 1 : t + 128;
    for (int tk = lo; tk <= hi; ++tk) {
        const size_t mk = (size_t)bb * T_ + tk;
        float s = 0.f;
#pragma unroll
        for (int d = 0; d < 64; ++d) s = fmaf(q[d], bf2f(b.KB[mk * 128 + kvh * 64 + d]), s);
        s = s * 0.125f + t5[t5_bucket(tk - t) * 8 + h];
        const float mn = fmaxf(mx, s), f = __expf(mx - mn), p = __expf(s - mn);
        l = l * f + p; mx = mn;
#pragma unroll
        for (int d = 0; d < 64; ++d) o[d] = o[d] * f + p * bf2f(b.VB[mk * 128 + kvh * 64 + d]);
    }
    const float il = 1.0f / l;
#pragma unroll
    for (int d = 0; d < 64; ++d) b.OB[(size_t)m * 512 + h * 64 + d] = f2bf(o[d] * il);
}

__global__ void __launch_bounds__(256) k_branch(const float* __restrict__ wba, const float* __restrict__ wbb, Bufs b) {
    __shared__ float As[16 * 65], Bs[16 * 64];
    const int n0 = blockIdx.x * 64, m0 = blockIdx.y * 64, tid = threadIdx.x, tx = tid & 15, ty = tid >> 4;
    float a1[4][4], a2[4][4];
    tile_gemm(a1, [&](int m, int k) { return bf2f(b.OA[(size_t)m * 512 + k]); }, wba, D_, 512, m0, n0, As, Bs);
    tile_gemm(a2, [&](int m, int k) { return bf2f(b.OB[(size_t)m * 512 + k]); }, wbb, D_, 512, m0, n0, As, Bs);
#pragma unroll
    for (int i = 0; i < 4; ++i) { const int m = m0 + ty * 4 + i;
#pragma unroll
        for (int j = 0; j < 4; ++j) { const int n = n0 + tx * 4 + j;
            const float ga = bf2f(b.GATE[(size_t)m * 2048 + n]), gb = bf2f(b.GATE[(size_t)m * 2048 + 1024 + n]);
            b.Y[(size_t)m * D_ + n] = f2bf(ga * a1[i][j] + gb * a2[i][j]); } }
}
__global__ void __launch_bounds__(256) k_outproj(const float* __restrict__ x, const float* __restrict__ wout, float* __restrict__ out, Bufs b) {
    __shared__ float As[16 * 65], Bs[16 * 64];
    const int n0 = blockIdx.x * 64, m0 = blockIdx.y * 64, tid = threadIdx.x, tx = tid & 15, ty = tid >> 4;
    float a1[4][4];
    tile_gemm(a1, [&](int m, int k) { return bf2f(b.Y[(size_t)m * D_ + k]); }, wout, D_, D_, m0, n0, As, Bs);
#pragma unroll
    for (int i = 0; i < 4; ++i) { const int m = m0 + ty * 4 + i;
#pragma unroll
        for (int j = 0; j < 4; ++j) { const int n = n0 + tx * 4 + j; const float v = x[(size_t)m * D_ + n] + a1[i][j];
            out[(size_t)m * D_ + n] = v; b.X1B[(size_t)m * D_ + n] = f2bf(v); } }
}
__global__ void __launch_bounds__(256) k_gateup(const float* __restrict__ x1, const float* __restrict__ g2, const float* __restrict__ wg, const float* __restrict__ wu, Bufs b) {
    __shared__ float As[16 * 65], Bs[16 * 64];
    const int n0 = blockIdx.x * 64, m0 = blockIdx.y * 64, tid = threadIdx.x, tx = tid & 15, ty = tid >> 4;
    float a1[4][4], a2[4][4];
    auto la = [&](int m, int k) { return x1[(size_t)m * D_ + k] * g2[k]; };
    tile_gemm(a1, la, wg, FF_, D_, m0, n0, As, Bs);
    tile_gemm(a2, la, wu, FF_, D_, m0, n0, As, Bs);
#pragma unroll
    for (int i = 0; i < 4; ++i) { const int m = m0 + ty * 4 + i;
        const float* s4 = b.SS + (size_t)m * 4; const float r = rsqrtf(((s4[0] + s4[1]) + (s4[2] + s4[3])) * (1.0f / D_) + 1e-6f);
#pragma unroll
        for (int j = 0; j < 4; ++j) { const int n = n0 + tx * 4 + j; const float g = a1[i][j] * r, u = a2[i][j] * r;
            b.U[(size_t)m * FF_ + n] = f2bf(g / (1.0f + expf(-g)) * u); } }
}
__global__ void __launch_bounds__(256) k_down(const float* __restrict__ wd, float* __restrict__ out, Bufs b) {
    __shared__ float As[16 * 65], Bs[16 * 64];
    const int n0 = blockIdx.x * 64, m0 = blockIdx.y * 64, tid = threadIdx.x, tx = tid & 15, ty = tid >> 4;
    float a1[4][4];
    tile_gemm(a1, [&](int m, int k) { return bf2f(b.U[(size_t)m * FF_ + k]); }, wd, D_, FF_, m0, n0, As, Bs);
#pragma unroll
    for (int i = 0; i < 4; ++i) { const int m = m0 + ty * 4 + i;
#pragma unroll
        for (int j = 0; j < 4; ++j) { const int n = n0 + tx * 4 + j; out[(size_t)m * D_ + n] += a1[i][j]; } }
}
}

constexpr size_t MiB = 1u << 20;
constexpr size_t WS_RS1 = 30 * MiB, WS_SS = 30 * MiB + 512 * 1024;
constexpr size_t WS_XB = 32 * MiB, WS_QA = 64 * MiB, WS_KA = 80 * MiB, WS_VAT = 96 * MiB, WS_QB = 112 * MiB, WS_KB = 128 * MiB, WS_VB = 132 * MiB;
constexpr size_t WS_GATE = 136 * MiB, WS_OA = 200 * MiB, WS_OB = 216 * MiB, WS_Y = WS_XB, WS_X1B = WS_OA, WS_U = 64 * MiB;

extern "C" void kernel_launch(void* const* d_in, const int* in_sizes, int n_in, void* d_out, int out_size, void* d_ws, size_t ws_size, hipStream_t stream) {
    using namespace nv;
    const float* x = (const float*)d_in[0]; const float* g1 = (const float*)d_in[1]; const float* w_in = (const float*)d_in[2];
    const float* qna = (const float*)d_in[3]; const float* kna = (const float*)d_in[4]; const float* rpb = (const float*)d_in[5];
    const float* qnb = (const float*)d_in[6]; const float* knb = (const float*)d_in[7]; const float* sink = (const float*)d_in[8]; const float* t5 = (const float*)d_in[9];
    const float* wba = (const float*)d_in[10]; const float* wbb = (const float*)d_in[11]; const float* wout = (const float*)d_in[12]; const float* g2 = (const float*)d_in[13];
    const float* wg = (const float*)d_in[14]; const float* wu = (const float*)d_in[15]; const float* wd = (const float*)d_in[16];
    float* out = (float*)d_out; unsigned char* ws = (unsigned char*)d_ws;
    Bufs b;
    b.QA = (bf16*)(ws + WS_QA); b.KA = (bf16*)(ws + WS_KA); b.VAT = (bf16*)(ws + WS_VAT); b.QB = (bf16*)(ws + WS_QB); b.KB = (bf16*)(ws + WS_KB); b.VB = (bf16*)(ws + WS_VB);
    b.GATE = (bf16*)(ws + WS_GATE); b.OA = (bf16*)(ws + WS_OA); b.OB = (bf16*)(ws + WS_OB); b.Y = (bf16*)(ws + WS_Y); b.X1B = (bf16*)(ws + WS_X1B); b.U = (bf16*)(ws + WS_U);
    b.RS1 = (float*)(ws + WS_RS1); b.SS = (float*)(ws + WS_SS);
    k_rowscale<<<M_ / 4, 256, 0, stream>>>(x, b.RS1);
    k_inproj<<<dim3(NIN_ / 64, M_ / 64), 256, 0, stream>>>(x, g1, b.RS1, w_in, qna, kna, qnb, knb, b);
    k_natten<<<M_ * 8 / 256, 256, 0, stream>>>(rpb, b);
    k_swa<<<M_ * 8 / 256, 256, 0, stream>>>(sink, t5, b);
    k_branch<<<dim3(D_ / 64, M_ / 64), 256, 0, stream>>>(wba, wbb, b);
    k_outproj<<<dim3(D_ / 64, M_ / 64), 256, 0, stream>>>(x, wout, out, b);
    k_rowss<<<M_ / 4, 256, 0, stream>>>(out, b.SS);
    k_gateup<<<dim3(FF_ / 64, M_ / 64), 256, 0, stream>>>(out, g2, wg, wu, b);
    k_down<<<dim3(D_ / 64, M_ / 64), 256, 0, stream>>>(wd, out, b);
}
```

```cpp
#include <hip/hip_runtime.h>
#include <cstdio>
#include <cstdint>
#ifdef MK_DEBUG_MASK
#include <hip/hip_runtime.h>
#include <cstdint>
#include <cstddef>
namespace nv {
typedef unsigned short bf16;
__device__ __forceinline__ float bf2f(bf16 v) { return __uint_as_float(((unsigned)v) << 16); }
__device__ __forceinline__ bf16 f2bf(float f) { unsigned u = __float_as_uint(f); return (bf16)((u + 0x7fffu + ((u >> 16) & 1u)) >> 16); }

constexpr float QK_C2N = 0.125f * 1.4426950408889634f, LOG2EN = 1.4426950408889634f;
__host__ __device__ __forceinline__ size_t kblk(int nh, int b, int t, int h, int d) { return ((((size_t)(b * 1024 + (t >> 3)) * nh + h) * 8 + (d >> 3)) * 8 + (t & 7)) * 8 + (d & 7); }
__host__ __device__ __forceinline__ size_t vblk(int nh, int b, int t, int h, int d) { return (((size_t)(b * 1024 + (t >> 3)) * nh + h) * 64 + d) * 8 + (t & 7); }
constexpr int B_ = 2, T_ = 8192, D_ = 1024, M_ = B_ * T_, FF_ = 2816, NIN_ = 4352;

__global__ void k_rowscale(const float* __restrict__ x, float* __restrict__ rs) {
    const int gw = (blockIdx.x * blockDim.x + threadIdx.x) >> 6, lane = threadIdx.x & 63;
    if (gw >= M_) return;
    const float* r = x + (size_t)gw * D_;
    float s = 0.f;
    for (int i = lane; i < D_; i += 64) { const float v = r[i]; s += v * v; }
    for (int o = 1; o < 64; o <<= 1) s += __shfl_xor(s, o);
    if (lane == 0) rs[gw] = rsqrtf(s * (1.0f / D_) + 1e-6f);
}
__global__ void k_rowss(const float* __restrict__ x, float* __restrict__ ss) {
    const int gw = (blockIdx.x * blockDim.x + threadIdx.x) >> 6, lane = threadIdx.x & 63;
    if (gw >= M_) return;
    const float* r = x + (size_t)gw * D_;
    float s = 0.f;
    for (int i = lane; i < D_; i += 64) { const float v = r[i]; s += v * v; }
    for (int o = 1; o < 64; o <<= 1) s += __shfl_xor(s, o);
    if (lane < 4) ss[(size_t)gw * 4 + lane] = lane == 0 ? s : 0.f;
}

template <class LA>
__device__ __forceinline__ void tile_gemm(float (&acc)[4][4], LA la, const float* __restrict__ Bm, int ldb, int K, int m0, int n0, float* As, float* Bs) {
    const int tid = threadIdx.x, tx = tid & 15, ty = tid >> 4;
#pragma unroll
    for (int i = 0; i < 4; ++i)
#pragma unroll
        for (int j = 0; j < 4; ++j) acc[i][j] = 0.f;
    for (int k0 = 0; k0 < K; k0 += 16) {
#pragma unroll
        for (int i = 0; i < 4; ++i) { const int e = tid + i * 256, r = e >> 4, kk = e & 15; As[kk * 65 + r] = la(m0 + r, k0 + kk); }
#pragma unroll
        for (int i = 0; i < 4; ++i) { const int e = tid + i * 256, kk = e >> 6, c = e & 63; Bs[kk * 64 + c] = Bm[(size_t)(k0 + kk) * ldb + n0 + c]; }
        __syncthreads();
#pragma unroll
        for (int kk = 0; kk < 16; ++kk) {
            float a[4], b[4];
#pragma unroll
            for (int i = 0; i < 4; ++i) a[i] = As[kk * 65 + ty * 4 + i];
#pragma unroll
            for (int j = 0; j < 4; ++j) b[j] = Bs[kk * 64 + tx * 4 + j];
#pragma unroll
            for (int i = 0; i < 4; ++i)
#pragma unroll
                for (int j = 0; j < 4; ++j) acc[i][j] = fmaf(a[i], b[j], acc[i][j]);
        }
        __syncthreads();
    }
}

struct Bufs {
    bf16 *QA, *KA, *VAT, *QB, *KB, *VBT, *GATE, *OA, *OB, *Y, *X1B, *U;
    float *RS1, *SS;
};

__global__ void __launch_bounds__(256) k_inproj(const float* __restrict__ x, const float* __restrict__ g1, const float* __restrict__ rs1, const float* __restrict__ w_in,
                                                const float* __restrict__ qna, const float* __restrict__ kna, const float* __restrict__ qnb, const float* __restrict__ knb, Bufs b) {
    __shared__ float As[16 * 65], Bs[16 * 64], red[64 * 17];
    const int n0 = blockIdx.x * 64, m0 = blockIdx.y * 64, tid = threadIdx.x, tx = tid & 15, ty = tid >> 4;
    float acc[4][4];
    tile_gemm(acc, [&](int m, int k) { return x[(size_t)m * D_ + k] * g1[k]; }, w_in, NIN_, D_, m0, n0, As, Bs);
#pragma unroll
    for (int i = 0; i < 4; ++i) { const float r = rs1[m0 + ty * 4 + i];
#pragma unroll
        for (int j = 0; j < 4; ++j) acc[i][j] *= r; }
    const float* gn = nullptr;
    if (n0 < 512) gn = qna; else if (n0 < 1024) gn = kna; else if (n0 >= 1536 && n0 < 2048) gn = qnb; else if (n0 >= 2048 && n0 < 2176) gn = knb;
    if (gn) {
#pragma unroll
        for (int i = 0; i < 4; ++i) { float s = 0.f;
#pragma unroll
            for (int j = 0; j < 4; ++j) s += acc[i][j] * acc[i][j];
            red[(ty * 4 + i) * 17 + tx] = s; }
        __syncthreads();
#pragma unroll
        for (int i = 0; i < 4; ++i) { float s = 0.f;
            for (int t = 0; t < 16; ++t) s += red[(ty * 4 + i) * 17 + t];
            const float r = rsqrtf(s * (1.0f / 64.0f) + 1e-6f);
#pragma unroll
            for (int j = 0; j < 4; ++j) acc[i][j] = acc[i][j] * r * gn[tx * 4 + j]; }
    }
#pragma unroll
    for (int i = 0; i < 4; ++i) { const int m = m0 + ty * 4 + i;
#pragma unroll
        for (int j = 0; j < 4; ++j) { const int n = n0 + tx * 4 + j; const float v = acc[i][j];
            if (n < 512) b.QA[(size_t)m * 512 + n] = f2bf(v * QK_C2N);
            else if (n < 1024) { const int c = n - 512; b.KA[kblk(8, m / T_, m % T_, c >> 6, c & 63)] = f2bf(v); }
            else if (n < 1536) { const int c = n - 1024, h = c >> 6, d = c & 63, bb = m / T_, t = m % T_; b.VAT[vblk(8, bb, t, h, d)] = f2bf(v); }
            else if (n < 2048) b.QB[(size_t)m * 512 + (n - 1536)] = f2bf(v * QK_C2N);
            else if (n < 2176) { const int c = n - 2048; b.KB[kblk(2, m / T_, m % T_, c >> 6, c & 63)] = f2bf(v); }
            else if (n < 2304) { const int c = n - 2176, h = c >> 6, d = c & 63, bb = m / T_, t = m % T_; b.VBT[vblk(2, bb, t, h, d)] = f2bf(v); }
            else b.GATE[(size_t)m * 2048 + (n - 2304)] = f2bf(1.0f / (1.0f + expf(-v))); } }
}

__global__ void __launch_bounds__(256) k_natten(const float* __restrict__ rpb, Bufs b) {
    const int gid = blockIdx.x * 256 + threadIdx.x; if (gid >= M_ * 8) return;
    const int h = gid & 7, m = gid >> 3, bb = m / T_, t = m % T_, r = t >> 6, qc = t & 63;
    int rs = r - 4; rs = rs < 0 ? 0 : (rs > 120 ? 120 : rs);
    int ws = qc - 8; ws = ws < 0 ? 0 : (ws > 48 ? 48 : ws);
    float q[64], o[64];
#pragma unroll
    for (int d = 0; d < 64; ++d) { q[d] = bf2f(b.QA[(size_t)m * 512 + h * 64 + d]); o[d] = 0.f; }
    float mx = -3.0e38f, l = 0.f;
    for (int kr = 0; kr < 8; ++kr)
        for (int kc = 0; kc < 16; ++kc) {
            const int krow = rs + kr, kcol = ws + kc, tk = krow * 64 + kcol; const size_t mk = (size_t)bb * T_ + tk;
            float s = 0.f;
#pragma unroll
            for (int d = 0; d < 64; ++d) s = fmaf(q[d], bf2f(b.KA[kblk(8, bb, tk, h, d)]), s);
            const int dr = krow - r + 7, dc = kcol - qc + 15;
            s = s + rpb[(dr * 31 + dc) * 8 + h] * LOG2EN;
            const float mn = fmaxf(mx, s), f = exp2f(mx - mn), p = exp2f(s - mn);
            l = l * f + p; mx = mn;
#pragma unroll
            for (int d = 0; d < 64; ++d) o[d] = o[d] * f + p * bf2f(b.VAT[vblk(8, bb, tk, h, d)]);
        }
    const float il = 1.0f / l;
#pragma unroll
    for (int d = 0; d < 64; ++d) b.OA[(size_t)m * 1024 + h * 64 + d] = f2bf(o[d] * il);
}

__device__ __forceinline__ int t5_bucket(int rel) {
    const int n = rel < 0 ? -rel : rel;
    const int large = 8 + (n >= 12) + (n >= 16) + (n >= 23) + (n >= 32) + (n >= 46) + (n >= 64) + (n >= 91);
    return (rel > 0 ? 16 : 0) + (n < 8 ? n : large);
}
__global__ void __launch_bounds__(256) k_swa(const float* __restrict__ sink, const float* __restrict__ t5, Bufs b) {
    const int gid = blockIdx.x * 256 + threadIdx.x; if (gid >= M_ * 8) return;
    const int h = gid & 7, m = gid >> 3, bb = m / T_, t = m % T_, kvh = h >> 2;
    float q[64], o[64];
#pragma unroll
    for (int d = 0; d < 64; ++d) { q[d] = bf2f(b.QB[(size_t)m * 512 + h * 64 + d]); o[d] = 0.f; }
    float mx = sink[h] * LOG2EN, l = 1.0f;
    const int lo = t - 128 < 0 ? 0 : t - 128, hi = t + 128 > T_ - 1 ? T_ - 1 : t + 128;
    for (int tk = lo; tk <= hi; ++tk) {
        const size_t mk = (size_t)bb * T_ + tk;
        float s = 0.f;
#pragma unroll
        for (int d = 0; d < 64; ++d) s = fmaf(q[d], bf2f(b.KB[kblk(2, bb, tk, kvh, d)]), s);
        s = s + t5[t5_bucket(tk - t) * 8 + h] * LOG2EN;
        const float mn = fmaxf(mx, s), f = exp2f(mx - mn), p = exp2f(s - mn);
        l = l * f + p; mx = mn;
#pragma unroll
        for (int d = 0; d < 64; ++d) o[d] = o[d] * f + p * bf2f(b.VBT[vblk(2, bb, tk, kvh, d)]);
    }
    const float il = 1.0f / l;
#pragma unroll
    for (int d = 0; d < 64; ++d) b.OB[(size_t)m * 1024 + h * 64 + d] = f2bf(o[d] * il);
}

__global__ void __launch_bounds__(256) k_gatefix(Bufs b) {
    const size_t i = (size_t)blockIdx.x * 256 + threadIdx.x; const size_t m = i >> 10, n = i & 1023;
    const float sa = bf2f(b.GATE[m * 2048 + n]), sb = bf2f(b.GATE[m * 2048 + 1024 + n]);
    b.GATE[m * 2048 + n] = f2bf(sa / sb);
}
__global__ void __launch_bounds__(256) k_branch(const float* __restrict__ wba, const float* __restrict__ wbb, Bufs b) {
    __shared__ float As[16 * 65], Bs[16 * 64];
    const int n0 = blockIdx.x * 64, m0 = blockIdx.y * 64, tid = threadIdx.x, tx = tid & 15, ty = tid >> 4;
    float a1[4][4], a2[4][4];
    tile_gemm(a1, [&](int m, int k) { return bf2f(b.OA[(size_t)m * 1024 + k]); }, wba, D_, 512, m0, n0, As, Bs);
    tile_gemm(a2, [&](int m, int k) { return bf2f(b.OB[(size_t)m * 1024 + k]); }, wbb, D_, 512, m0, n0, As, Bs);
#pragma unroll
    for (int i = 0; i < 4; ++i) { const int m = m0 + ty * 4 + i;
#pragma unroll
        for (int j = 0; j < 4; ++j) { const int n = n0 + tx * 4 + j;
            const float ga = bf2f(b.GATE[(size_t)m * 2048 + n]), gb = bf2f(b.GATE[(size_t)m * 2048 + 1024 + n]);
            b.Y[(size_t)m * D_ + n] = f2bf(gb * (ga * a1[i][j] + a2[i][j])); } }
}
__global__ void __launch_bounds__(256) k_outproj(const float* __restrict__ x, const float* __restrict__ wout, const float* __restrict__ g2, float* __restrict__ out, Bufs b) {
    __shared__ float As[16 * 65], Bs[16 * 64];
    const int n0 = blockIdx.x * 64, m0 = blockIdx.y * 64, tid = threadIdx.x, tx = tid & 15, ty = tid >> 4;
    float a1[4][4];
    tile_gemm(a1, [&](int m, int k) { return bf2f(b.Y[(size_t)m * D_ + k]); }, wout, D_, D_, m0, n0, As, Bs);
#pragma unroll
    for (int i = 0; i < 4; ++i) { const int m = m0 + ty * 4 + i;
#pragma unroll
        for (int j = 0; j < 4; ++j) { const int n = n0 + tx * 4 + j; const float v = x[(size_t)m * D_ + n] + a1[i][j];
            out[(size_t)m * D_ + n] = v; b.X1B[(size_t)m * D_ + n] = f2bf(v * g2[n]); } }
}
__global__ void __launch_bounds__(256) k_gateup(const float* __restrict__ x1, const float* __restrict__ g2, const float* __restrict__ wg, const float* __restrict__ wu, Bufs b) {
    __shared__ float As[16 * 65], Bs[16 * 64];
    const int n0 = blockIdx.x * 64, m0 = blockIdx.y * 64, tid = threadIdx.x, tx = tid & 15, ty = tid >> 4;
    float a1[4][4], a2[4][4];
    auto la = [&](int m, int k) { return x1[(size_t)m * D_ + k] * g2[k]; };
    tile_gemm(a1, la, wg, FF_, D_, m0, n0, As, Bs);
    tile_gemm(a2, la, wu, FF_, D_, m0, n0, As, Bs);
#pragma unroll
    for (int i = 0; i < 4; ++i) { const int m = m0 + ty * 4 + i;
        const float* s4 = b.SS + (size_t)m * 4; const float r = rsqrtf(((s4[0] + s4[1]) + (s4[2] + s4[3])) * (1.0f / D_) + 1e-6f);
#pragma unroll
        for (int j = 0; j < 4; ++j) { const int n = n0 + tx * 4 + j; const float g = a1[i][j] * r, u = a2[i][j] * r;
            b.U[(size_t)m * FF_ + n] = f2bf(g / (1.0f + expf(-g)) * u); } }
}
__global__ void __launch_bounds__(256) k_down(const float* __restrict__ wd, float* __restrict__ out, Bufs b) {
    __shared__ float As[16 * 65], Bs[16 * 64];
    const int n0 = blockIdx.x * 64, m0 = blockIdx.y * 64, tid = threadIdx.x, tx = tid & 15, ty = tid >> 4;
    float a1[4][4];
    tile_gemm(a1, [&](int m, int k) { return bf2f(b.U[(size_t)m * FF_ + k]); }, wd, D_, FF_, m0, n0, As, Bs);
#pragma unroll
    for (int i = 0; i < 4; ++i) { const int m = m0 + ty * 4 + i;
#pragma unroll
        for (int j = 0; j < 4; ++j) { const int n = n0 + tx * 4 + j; out[(size_t)m * D_ + n] += a1[i][j]; } }
}
}
#endif
#if defined(MK_STAMP_A) && MK_STAMP_A >= 40
#define PG8_KSTAMP_BEGIN() const unsigned kst0_ = (unsigned)__builtin_amdgcn_s_memrealtime()
#define PG8_KSTAMP_END() do { if (tid == 0) ((PG8_LAS unsigned*)(lds + (155648 - 1024) + 128))[0] += (unsigned)__builtin_amdgcn_s_memrealtime() - kst0_; } while (0)
#if MK_STAMP_A >= 60
#ifndef MK_TRIP_T
#define MK_TRIP_T 2
#endif
#define PG8_KSTAMP_TRIP() do { if (tid == 0 && ui == 0 && t == MK_TRIP_T) ((PG8_LAS unsigned*)(lds + (155648 - 1024) + 128))[1] = (unsigned)__builtin_amdgcn_s_memrealtime() - kst0_; } while (0)
#else
#define PG8_KSTAMP_TRIP() do {} while (0)
#endif
#endif
namespace pg8 {
#define PG8_LAS __attribute__((address_space(3)))
typedef unsigned short bf16_t;
typedef short bf16x8 __attribute__((ext_vector_type(8)));
typedef float f32x4 __attribute__((ext_vector_type(4)));
typedef unsigned u32x4 __attribute__((ext_vector_type(4)));
constexpr int BM = 256, BK = 64, HALF = 128, HTB = HALF * BK * 2  , STAGE_BYTES = 8 * HTB, NXCD = 8, WGM = 8;

__host__ __device__ __forceinline__ int lds_byte(int r, int c) { const int st = (r >> 4) * 2 + (c >> 5), rr = r & 15, cc = c & 31, ob = rr * 64 + cc * 2; return st * 1024 + (ob ^ (((ob >> 9) & 1) << 5)); }
__host__ __device__ __forceinline__ void stage_rc(int b, int& R, int& C) { const int st = b / 1024, sb = b % 1024, swz = sb ^ (((sb >> 9) & 1) << 5); R = (st >> 1) * 16 + swz / 64; C = (st & 1) * 32 + (swz % 64) / 2; }
__host__ __device__ __forceinline__ int perm32(int rho) { const int n = rho >> 4, i = rho & 15; return 8 * (i >> 2) + 4 * n + (i & 3); }

struct Unit { int pm, pn; };
struct Gemm { const bf16_t* A; const bf16_t* Bt; int M, N, K; };

struct StaticOrder {
    int nM, nN, nwg, G, c, wgm;
    __host__ __device__ void init(int M, int N, int G_, int c_, int wgm_ = WGM) { nM = M / BM; nN = N / BM; nwg = nM * nN; G = G_; c = c_; wgm = wgm_; }
    __host__ __device__ bool next(int i, Unit& u) const {
        const long L = (long)i * G + c; if (L >= nwg) return false;
        int wgid = (int)L; { const int q = nwg / NXCD, r = nwg % NXCD, xcd = wgid % NXCD, off = wgid / NXCD; wgid = (xcd < r ? xcd * (q + 1) : r * (q + 1) + (xcd - r) * q) + off; }
        const int nig = wgm * nN, gid = wgid / nig, fm = gid * wgm, gsz = (nM - fm) < wgm ? (nM - fm) : wgm;
        u.pm = fm + ((wgid % nig) % gsz); u.pn = (wgid % nig) / gsz; return true;
    }
    __device__ __forceinline__ void a_ready(const Unit&) const {}
    __device__ __forceinline__ void done(const Unit&) const {}
};
__device__ __forceinline__ unsigned cvt_pk_bf16(float lo, float hi) { unsigned r; asm volatile("v_cvt_pk_bf16_f32 %0, %1, %2" : "=v"(r) : "v"(lo), "v"(hi)); return r; }
typedef float f32x2 __attribute__((ext_vector_type(2)));
#ifndef EPI_NT
#define EPI_NT 0
#endif
#if EPI_NT
#define EPI_ST(p, v) __builtin_nontemporal_store((v), (p))
#else
#define EPI_ST(p, v) (*(p) = (v))
#endif
#ifndef EPI_INIT_ACC
#define EPI_INIT_ACC 1
#endif
#ifndef EPI_NT_LD
#define EPI_NT_LD 1
#endif
#if EPI_NT_LD
#define EPI_LD(p) __builtin_nontemporal_load(p)
#else
#define EPI_LD(p) (*(p))
#endif
#ifndef EPI_WT
#define EPI_WT 1
#endif
#ifndef EPI_WT_QKV
#define EPI_WT_QKV 0
#endif
#ifndef EPI_WT_Y
#define EPI_WT_Y 0
#endif
typedef int epi_i32x4 __attribute__((ext_vector_type(4)));
__device__ __forceinline__ void store_wt16(void* p, u32x4 v) {
#if EPI_WT
    *(u32x4*)p = v;
#else
    *(u32x4*)p = v;
#endif
}
__device__ __forceinline__ void store_wt16(const __amdgpu_buffer_rsrc_t rsrc, unsigned byte_off, u32x4 v) {
    __builtin_amdgcn_raw_buffer_store_b128(__builtin_bit_cast(epi_i32x4, v), rsrc, (int)byte_off, 0, 16  );
}
typedef int epi_i32x2 __attribute__((ext_vector_type(2)));
__device__ __forceinline__ void store_wt8(const __amdgpu_buffer_rsrc_t rsrc, unsigned byte_off, unsigned lo, unsigned hi) {
    __builtin_amdgcn_raw_buffer_store_b64((epi_i32x2){(int)lo, (int)hi}, rsrc, (int)byte_off, 0, 16);
}
#define EPI_RSRC(p) __builtin_amdgcn_make_buffer_rsrc((void*)(p), 0, 0x7fffffff, 0x00020000)
constexpr float QK_C2 = 0.125f * 1.4426950408889634f;
constexpr float LOG2E = 1.4426950408889634f;
constexpr int EP_T = 8192;
typedef float epi_f32x2 __attribute__((ext_vector_type(2)));
typedef __bf16 epi_bf16x2 __attribute__((ext_vector_type(2)));
__device__ __forceinline__ unsigned cvt_pk_safe(float lo, float hi) { epi_f32x2 v = {lo, hi}; epi_bf16x2 b = __builtin_convertvector(v, epi_bf16x2); return __builtin_bit_cast(unsigned, b); }
__device__ __forceinline__ float fast_sigmoid(float v) { return __builtin_amdgcn_rcpf(1.0f + __builtin_amdgcn_exp2f(-LOG2E * v)); }
__device__ __forceinline__ float bf_lo(unsigned w) { return __uint_as_float(w << 16); }
__device__ __forceinline__ float bf_hi(unsigned w) { return __uint_as_float(w & 0xffff0000u); }

__device__ __forceinline__ size_t gate_blk(int pm, int q, int half, int ai, int m, int wr, int wc) { return (size_t)(((((((pm * 8 + q) * 2 + half) * 2 + ai) * 4 + m) * 2 + wr) * 4 + wc)) * 512; }
struct EpiInProj {
    static constexpr bool INIT_ACC = false;
    static constexpr bool PERM = true, AFTER_DRAIN = false; static constexpr int MID_T = -1;
    bf16_t *QA, *KA, *VAT, *QB, *KB, *VBT, *GATE; const PG8_LAS float *qna, *kna, *qnb, *knb;
    template <int MODE, int NH = 0> __device__ __forceinline__ void rowmajor(const f32x4 (&acc)[2][2][4][2], bf16_t* dst, int ld, int row0, int fq, const PG8_LAS float* gain, float scale, int hb = 0) const {
        const __amdgpu_buffer_rsrc_t drs = EPI_RSRC(dst);
        f32x4 g[2][2];
        if (MODE == 1) {
#pragma unroll
            for (int bj = 0; bj < 2; ++bj)
#pragma unroll
                for (int n = 0; n < 2; ++n) g[bj][n] = *(const PG8_LAS f32x4*)(gain + 32 * bj + 8 * fq + 4 * n) * scale;
        }
#pragma unroll
        for (int ai = 0; ai < 2; ++ai)
#pragma unroll
            for (int m = 0; m < 4; ++m) {
                const int t_ = row0 + ai * HALF + m * 16;
                bf16_t* rowp = NH ? dst + ((size_t)((t_ >> 3) * NH + hb) * 64 + fq * 8 + (t_ & 7)) * 8 : dst + (size_t)t_ * ld + 8 * fq;
                f32x4 v[2][2];
#pragma unroll
                for (int bj = 0; bj < 2; ++bj)
#pragma unroll
                    for (int n = 0; n < 2; ++n) v[bj][n] = acc[ai][bj][m][n];
                if (MODE == 1) {
                    float ss = 0.f;
#pragma unroll
                    for (int bj = 0; bj < 2; ++bj)
#pragma unroll
                        for (int n = 0; n < 2; ++n) { const f32x4 x = v[bj][n]; ss += (x[0] * x[0] + x[1] * x[1]) + (x[2] * x[2] + x[3] * x[3]); }
                    ss += __shfl_xor(ss, 16); ss += __shfl_xor(ss, 32);
                    const float r = __builtin_amdgcn_rsqf(ss * (1.0f / 64.0f) + 1e-6f);
#pragma unroll
                    for (int bj = 0; bj < 2; ++bj)
#pragma unroll
                        for (int n = 0; n < 2; ++n) v[bj][n] = v[bj][n] * r * g[bj][n];
                } else if (MODE == 2) {
#pragma unroll
                    for (int bj = 0; bj < 2; ++bj)
#pragma unroll
                        for (int n = 0; n < 2; ++n)
#pragma unroll
                            for (int e = 0; e < 4; ++e) v[bj][n][e] = fast_sigmoid(v[bj][n][e]);
                }
#pragma unroll
                for (int bj = 0; bj < 2; ++bj) { u32x4 w; w.x = cvt_pk_safe(v[bj][0][0], v[bj][0][1]); w.y = cvt_pk_safe(v[bj][0][2], v[bj][0][3]); w.z = cvt_pk_safe(v[bj][1][0], v[bj][1][1]); w.w = cvt_pk_safe(v[bj][1][2], v[bj][1][3]);
                    if (EPI_WT_QKV) store_wt16(drs, (unsigned)((size_t)((rowp + (NH ? 256 : 32) * bj) - dst) * 2), w); else EPI_ST((u32x4*)(rowp + (NH ? 256 : 32) * bj), w); }
            }
    }
    template <int NH> __device__ __forceinline__ void vblocked(const f32x4 (&acc)[2][2][4][2], bf16_t* dst, int t0, int fq, int hb) const {
#pragma unroll
        for (int ai = 0; ai < 2; ++ai)
#pragma unroll
            for (int m = 0; m < 4; ++m) { const int t_ = t0 + ai * HALF + m * 16; bf16_t* tp = dst + ((size_t)((t_ >> 3) * NH + hb) * 64 + 8 * fq) * 8 + (t_ & 7);
#pragma unroll
                for (int bj = 0; bj < 2; ++bj)
#pragma unroll
                    for (int n = 0; n < 2; ++n)
#pragma unroll
                        for (int e = 0; e < 4; e += 2) { const unsigned w = cvt_pk_safe(acc[ai][bj][m][n][e], acc[ai][bj][m][n][e + 1]); const int d = 32 * bj + 4 * n + e;
                            tp[d * 8] = (bf16_t)(w & 0xffffu); tp[(d + 1) * 8] = (bf16_t)(w >> 16); } }
    }
    __device__ __forceinline__ void operator()(const f32x4 (&acc)[2][2][4][2], const Unit& u, int wr, int wc, int fr, int fq) const {
        asm volatile("" : "+v"(fr), "+v"(fq));
        const int pn = u.pn, row0 = u.pm * BM + wr * 64 + fr;
        const int b = (u.pm * BM) / EP_T, t0 = (u.pm * BM) % EP_T + wr * 64 + fr;
        if (pn < 2) rowmajor<1>(acc, QA + pn * 256 + 64 * wc, 512, row0, fq, qna, QK_C2);
        else if (pn < 4) rowmajor<1, 8>(acc, KA, 0, t0, fq, kna, 1.0f, b * 1024 * 8 + (pn - 2) * 4 + wc);
        else if (pn < 6) vblocked<8>(acc, VAT, t0, fq, b * 1024 * 8 + (pn - 4) * 4 + wc);
        else if (pn < 8) rowmajor<1>(acc, QB + (pn - 6) * 256 + 64 * wc, 512, row0, fq, qnb, QK_C2);
        else if (pn == 8) { if (wc < 2) rowmajor<1, 2>(acc, KB, 0, t0, fq, knb, 1.0f, b * 1024 * 2 + wc);
                            else vblocked<2>(acc, VBT, t0, fq, b * 1024 * 2 + (wc - 2)); }
        else gates(acc, GATE, u.pm, pn - 9, wr, wc, fr + 16 * fq);
    }
    __device__ __forceinline__ void gates(const f32x4 (&acc)[2][2][4][2], bf16_t* dst  , int pm, int q, int wr, int wc, int lane) const {
        const __amdgpu_buffer_rsrc_t grs = EPI_RSRC(dst);
#pragma unroll
        for (int ai = 0; ai < 2; ++ai)
#pragma unroll
            for (int m = 0; m < 4; ++m) { bf16_t* p1 = dst + gate_blk(pm, q, 0, ai, m, wr, wc) + lane * 8; bf16_t* p2 = dst + gate_blk(pm, q, 1, ai, m, wr, wc) + lane * 8; float g1[8], g2[8];
#pragma unroll
                for (int n = 0; n < 2; ++n)
#pragma unroll
                    for (int e = 0; e < 4; ++e) { const float ea = __builtin_amdgcn_exp2f(-LOG2E * acc[ai][0][m][n][e]), eb = fminf(__builtin_amdgcn_exp2f(-LOG2E * acc[ai][1][m][n][e]), 1.0e30f);
                        g2[4 * n + e] = __builtin_amdgcn_rcpf(1.0f + eb); g1[4 * n + e] = (1.0f + eb) * __builtin_amdgcn_rcpf(1.0f + ea); }
                u32x4 w1, w2;
                w1.x = cvt_pk_safe(g1[0], g1[1]); w1.y = cvt_pk_safe(g1[2], g1[3]); w1.z = cvt_pk_safe(g1[4], g1[5]); w1.w = cvt_pk_safe(g1[6], g1[7]);
                w2.x = cvt_pk_safe(g2[0], g2[1]); w2.y = cvt_pk_safe(g2[2], g2[3]); w2.z = cvt_pk_safe(g2[4], g2[5]); w2.w = cvt_pk_safe(g2[6], g2[7]);
                if (EPI_WT_QKV) { store_wt16(grs, (unsigned)((size_t)(p1 - dst) * 2), w1); store_wt16(grs, (unsigned)((size_t)(p2 - dst) * 2), w2); } else { EPI_ST((u32x4*)p1, w1); EPI_ST((u32x4*)p2, w2); } }
    }
};

struct EpiBranch {
    static constexpr bool INIT_ACC = false;
    static constexpr bool PERM = true, AFTER_DRAIN = false; static constexpr int MID_T = 8;
    bf16_t* Y; const bf16_t* GATE;
    __device__ __forceinline__ int mid_t() const { return MID_T; }
    template <int OFF> __device__ __forceinline__ void scale(f32x4 (&acc)[2][2][4][2], const Unit& u, int wr, int wc, int fr, int fq, bool store) const {
        asm volatile("" : "+v"(fr), "+v"(fq));
        const int row0 = u.pm * BM + wr * 64 + fr, col0 = u.pn * BM + wc * 32 + 8 * fq;
        const __amdgpu_buffer_rsrc_t yrs = EPI_RSRC(Y);
#pragma unroll
        for (int ai = 0; ai < 2; ++ai)
#pragma unroll
            for (int m = 0; m < 4; ++m) { const size_t row = (size_t)(row0 + ai * HALF + m * 16);
#pragma unroll
                for (int bj = 0; bj < 2; ++bj) {
                    const u32x4 gw = EPI_LD((const u32x4*)(GATE + gate_blk(u.pm, 2 * u.pn + bj, OFF ? 1 : 0, ai, m, wr, wc) + (fr + 16 * fq) * 8));
                    f32x4 v0 = acc[ai][bj][m][0], v1 = acc[ai][bj][m][1];
                    v0[0] *= bf_lo(gw.x); v0[1] *= bf_hi(gw.x); v0[2] *= bf_lo(gw.y); v0[3] *= bf_hi(gw.y); v1[0] *= bf_lo(gw.z); v1[1] *= bf_hi(gw.z); v1[2] *= bf_lo(gw.w); v1[3] *= bf_hi(gw.w);
                    if (store) { u32x4 w; w.x = cvt_pk_safe(v0[0], v0[1]); w.y = cvt_pk_safe(v0[2], v0[3]); w.z = cvt_pk_safe(v1[0], v1[1]); w.w = cvt_pk_safe(v1[2], v1[3]);
                        if (EPI_WT_Y) store_wt16(yrs, (unsigned)((row * 1024 + col0 + bj * HALF) * 2), w); else *(u32x4*)(Y + row * 1024 + col0 + bj * HALF) = w; }
                    else { acc[ai][bj][m][0] = v0; acc[ai][bj][m][1] = v1; } } }
    }
    __device__ __forceinline__ void mid(f32x4 (&acc)[2][2][4][2], const Unit& u, int wr, int wc, int fr, int fq) const { scale<0>(acc, u, wr, wc, fr, fq, false); }
    __device__ __forceinline__ void operator()(const f32x4 (&acc)[2][2][4][2], const Unit& u, int wr, int wc, int fr, int fq) const {
        scale<1024>(const_cast<f32x4 (&)[2][2][4][2]>(acc), u, wr, wc, fr, fq, true); }
};

constexpr bool RES_PERM = true; constexpr int RC_FQ = RES_PERM ? 8 : 4, RC_N = RES_PERM ? 4 : 16;
__device__ __forceinline__ void add_residual_tile(f32x4 (&acc)[2][2][4][2], const float* src, const Unit& u, int wr, int wc, int fr, int fq) {
    asm volatile("" : "+v"(fr), "+v"(fq));
    const int row0 = u.pm * BM + wr * 64 + fr, col0 = u.pn * BM + wc * 32 + RC_FQ * fq;
#pragma unroll
    for (int ai = 0; ai < 2; ++ai) {
        f32x4 t[4][2][2];
#pragma unroll
        for (int m = 0; m < 4; ++m) { const float* rowp = src + (size_t)(row0 + ai * HALF + m * 16) * 1024 + col0;
#pragma unroll
            for (int bj = 0; bj < 2; ++bj)
#pragma unroll
                for (int n = 0; n < 2; ++n) t[m][bj][n] = EPI_LD((const f32x4*)(rowp + bj * HALF + n * RC_N)); }
        asm volatile("" : "+v"(t[0][0][0]), "+v"(t[0][0][1]), "+v"(t[0][1][0]), "+v"(t[0][1][1]), "+v"(t[1][0][0]), "+v"(t[1][0][1]), "+v"(t[1][1][0]), "+v"(t[1][1][1]),
                          "+v"(t[2][0][0]), "+v"(t[2][0][1]), "+v"(t[2][1][0]), "+v"(t[2][1][1]), "+v"(t[3][0][0]), "+v"(t[3][0][1]), "+v"(t[3][1][0]), "+v"(t[3][1][1]));
#pragma unroll
        for (int m = 0; m < 4; ++m)
#pragma unroll
            for (int bj = 0; bj < 2; ++bj)
#pragma unroll
                for (int n = 0; n < 2; ++n) acc[ai][bj][m][n] = acc[ai][bj][m][n] + t[m][bj][n];
        asm volatile("" ::: "memory"); }
}

__device__ __forceinline__ void add_residual_tile_bf16(f32x4 (&acc)[2][2][4][2], const bf16_t* src, const Unit& u, int wr, int wc, int fr, int fq) {
    typedef unsigned u32x2v __attribute__((ext_vector_type(2)));
    asm volatile("" : "+v"(fr), "+v"(fq));
    const int row0 = u.pm * BM + wr * 64 + fr, col0 = u.pn * BM + wc * 32 + RC_FQ * fq;
    u32x2v t[2][4][2][2];
#pragma unroll
    for (int ai = 0; ai < 2; ++ai)
#pragma unroll
        for (int m = 0; m < 4; ++m) { const bf16_t* rowp = src + (size_t)(row0 + ai * HALF + m * 16) * 1024 + col0;
#pragma unroll
            for (int bj = 0; bj < 2; ++bj)
#pragma unroll
                for (int n = 0; n < 2; ++n) t[ai][m][bj][n] = EPI_LD((const u32x2v*)(rowp + bj * HALF + n * RC_N)); }
#pragma unroll
    for (int ai = 0; ai < 2; ++ai)
        asm volatile("" : "+v"(t[ai][0][0][0]), "+v"(t[ai][0][0][1]), "+v"(t[ai][0][1][0]), "+v"(t[ai][0][1][1]), "+v"(t[ai][1][0][0]), "+v"(t[ai][1][0][1]), "+v"(t[ai][1][1][0]), "+v"(t[ai][1][1][1]),
                          "+v"(t[ai][2][0][0]), "+v"(t[ai][2][0][1]), "+v"(t[ai][2][1][0]), "+v"(t[ai][2][1][1]), "+v"(t[ai][3][0][0]), "+v"(t[ai][3][0][1]), "+v"(t[ai][3][1][0]), "+v"(t[ai][3][1][1]));
#pragma unroll
    for (int ai = 0; ai < 2; ++ai)
#pragma unroll
        for (int m = 0; m < 4; ++m)
#pragma unroll
            for (int bj = 0; bj < 2; ++bj)
#pragma unroll
                for (int n = 0; n < 2; ++n) { const u32x2v w = t[ai][m][bj][n]; acc[ai][bj][m][n] = acc[ai][bj][m][n] + (f32x4){bf_lo(w.x), bf_hi(w.x), bf_lo(w.y), bf_hi(w.y)}; }
}

struct EpiOut {
    static constexpr bool PERM = RES_PERM, AFTER_DRAIN = true; static constexpr int MID_T = EPI_INIT_ACC ? -1 : 0; static constexpr bool INIT_ACC = EPI_INIT_ACC;
    __device__ __forceinline__ void init_acc(f32x4 (&acc)[2][2][4][2], const Unit& u, int wr, int wc, int fr, int fq) const {
        const int row0 = u.pm * BM + wr * 64 + fr, col0 = u.pn * BM + wc * 32 + RC_FQ * fq;
#pragma unroll
        for (int ai = 0; ai < 2; ++ai)
#pragma unroll
            for (int m = 0; m < 4; ++m) { const float* rowp = x + (size_t)(row0 + ai * HALF + m * 16) * 1024 + col0;
#pragma unroll
                for (int bj = 0; bj < 2; ++bj)
#pragma unroll
                    for (int n = 0; n < 2; ++n) acc[ai][bj][m][n] = EPI_LD((const f32x4*)(rowp + bj * HALF + n * RC_N)); }
    }
    const float* x; float* out; bf16_t* X1B; const float* g2; float* SS; int midt;
    __device__ __forceinline__ int mid_t() const { return midt; }
    __device__ __forceinline__ void mid(f32x4 (&acc)[2][2][4][2], const Unit& u, int wr, int wc, int fr, int fq) const { add_residual_tile(acc, x, u, wr, wc, fr, fq); }
    __device__ __forceinline__ void fused(f32x4 (&acc)[2][2][4][2], const Unit& u, int wr, int wc, int fr, int fq, PG8_LAS unsigned char* lds, int wid, int lane) const {
        typedef unsigned u32x2v __attribute__((ext_vector_type(2)));
        PG8_LAS float* P = (PG8_LAS float*)lds;
        const __amdgpu_buffer_rsrc_t xrs = EPI_RSRC(X1B);
        const int col0 = u.pn * BM + wc * 32 + RC_FQ * fq;
        f32x4 gv[2][2];
#pragma unroll
        for (int bj = 0; bj < 2; ++bj)
#pragma unroll
            for (int n = 0; n < 2; ++n) gv[bj][n] = out ? *(const f32x4*)(g2 + col0 + bj * HALF + n * RC_N) : (f32x4){1.f, 1.f, 1.f, 1.f};
#pragma unroll
        for (int ai = 0; ai < 2; ++ai)
#pragma unroll
            for (int m = 0; m < 4; ++m) { const int r = ai * HALF + wr * 64 + m * 16 + fr; const size_t off = (size_t)(u.pm * BM + r) * 1024 + col0; float ss = 0.f;
#pragma unroll
                for (int bj = 0; bj < 2; ++bj)
#pragma unroll
                    for (int n = 0; n < 2; ++n) { const f32x4 v = acc[ai][bj][m][n];
                        if (out) *(f32x4*)(out + off + bj * HALF + n * RC_N) = v; ss += (v[0] * v[0] + v[1] * v[1]) + (v[2] * v[2] + v[3] * v[3]);
                        const f32x4 h = v * gv[bj][n]; u32x2v w; w.x = cvt_pk_safe(h[0], h[1]); w.y = cvt_pk_safe(h[2], h[3]); if (EPI_WT_Y) store_wt8(xrs, (unsigned)((off + bj * HALF + n * RC_N) * 2), w.x, w.y); else *(u32x2v*)(X1B + off + bj * HALF + n * RC_N) = w; }
                ss += __shfl_xor(ss, 16); ss += __shfl_xor(ss, 32);
                if (fq == 0) P[r * 4 + wc] = ss;
                if (m & 1) asm volatile("" ::: "memory"); }
        asm volatile("s_waitcnt lgkmcnt(0)" ::: "memory"); __builtin_amdgcn_s_barrier(); asm volatile("" ::: "memory");
        const int t = wid * 64 + lane;
        if (t < 256) { const float s = (P[t * 4 + 0] + P[t * 4 + 1]) + (P[t * 4 + 2] + P[t * 4 + 3]); SS[(size_t)(u.pm * BM + t) * 4 + u.pn] = s; }
    }
};

struct EpiGateUp {
    static constexpr bool INIT_ACC = false;
    static constexpr bool PERM = true, AFTER_DRAIN = false; static constexpr int MID_T = -1;
    const PG8_LAS float* R; bf16_t* U; int ldu;
    __device__ __forceinline__ void operator()(const f32x4 (&acc)[2][2][4][2], const Unit& u, int wr, int wc, int fr, int fq) const {
        asm volatile("" : "+v"(fr), "+v"(fq));
        const int row0 = u.pm * BM + wr * 64 + fr, col0 = u.pn * HALF + wc * 32 + 8 * fq;
        const __amdgpu_buffer_rsrc_t urs = __builtin_amdgcn_make_buffer_rsrc(U, 0, 0x7fffffff, 0x00020000);
#pragma unroll
        for (int ai = 0; ai < 2; ++ai)
#pragma unroll
            for (int m = 0; m < 4; ++m) { const size_t row = (size_t)(row0 + ai * HALF + m * 16);
                const float r = R[(row0 + ai * HALF + m * 16) & 2047];
                const float c1 = -LOG2E * r, c2 = r * r; u32x4 w;
#pragma unroll
                for (int n = 0; n < 2; ++n) { const f32x4 g4 = acc[ai][0][m][n], u4 = acc[ai][1][m][n];
#pragma unroll
                    for (int p = 0; p < 2; ++p) { const epi_f32x2 g = {g4[2 * p], g4[2 * p + 1]}, up = {u4[2 * p], u4[2 * p + 1]};
                        const epi_f32x2 a = g * c1; epi_f32x2 e = {__builtin_amdgcn_exp2f(a.x), __builtin_amdgcn_exp2f(a.y)}; e = e + 1.0f;
                        epi_f32x2 sg = {__builtin_amdgcn_rcpf(e.x), __builtin_amdgcn_rcpf(e.y)}; const epi_f32x2 hh = (g * up) * (sg * c2);
                        w[2 * n + p] = cvt_pk_safe(hh.x, hh.y); } }
                if (EPI_WT) store_wt16(urs, (unsigned)((row * ldu + col0) * 2), w); else EPI_ST((u32x4*)(U + row * ldu + col0), w); }
    }
};

struct EpiDown {
    static constexpr bool PERM = RES_PERM, AFTER_DRAIN = false; static constexpr int MID_T = EPI_INIT_ACC ? -1 : 0; static constexpr bool INIT_ACC = EPI_INIT_ACC;
    __device__ __forceinline__ void init_acc(f32x4 (&acc)[2][2][4][2], const Unit& u, int wr, int wc, int fr, int fq) const {
        if (x1b) add_residual_tile_bf16(acc, x1b, u, wr, wc, fr, fq); else add_residual_tile(acc, out, u, wr, wc, fr, fq);
    }
    float* out; int midt; const bf16_t* x1b;
    __device__ __forceinline__ int mid_t() const { return midt; }
    __device__ __forceinline__ void mid(f32x4 (&acc)[2][2][4][2], const Unit& u, int wr, int wc, int fr, int fq) const { if (x1b) add_residual_tile_bf16(acc, x1b, u, wr, wc, fr, fq); else add_residual_tile(acc, out, u, wr, wc, fr, fq); }
    __device__ __forceinline__ void operator()(const f32x4 (&acc)[2][2][4][2], const Unit& u, int wr, int wc, int fr, int fq) const {
        const int row0 = u.pm * BM + wr * 64 + fr, col0 = u.pn * BM + wc * 32 + RC_FQ * fq;
#pragma unroll
        for (int ai = 0; ai < 2; ++ai)
#pragma unroll
            for (int m = 0; m < 4; ++m) { float* rowp = out + (size_t)(row0 + ai * HALF + m * 16) * 1024 + col0;
#pragma unroll
                for (int bj = 0; bj < 2; ++bj)
#pragma unroll
                    for (int n = 0; n < 2; ++n) EPI_ST((f32x4*)(rowp + bj * HALF + n * RC_N), acc[ai][bj][m][n]); }
    }
};
#ifndef PG8_KSTAMP_BEGIN
#define PG8_KSTAMP_BEGIN() do {} while (0)
#define PG8_KSTAMP_END() do {} while (0)
#define PG8_KSTAMP_TRIP() do {} while (0)
#endif
#ifndef PG8_AUX_A
#define PG8_AUX_A 0
#endif
#ifndef PG8_AUX_B
#define PG8_AUX_B 0
#endif
template <class Epi, class Sched, bool ALIGN_EPI = false, bool SP2 = false>
__device__ __forceinline__ void gemm_phase(PG8_LAS unsigned char* lds, const Gemm g, const Sched& S, const Epi& E) {
    const int tid = threadIdx.x, wid = __builtin_amdgcn_readfirstlane(tid >> 6), lane = tid & 63, wr = wid >> 2, wc = wid & 3, fr = lane & 15, fq = lane >> 4;
    const int K = g.K, nt = K / BK;
    unsigned voffA[2], voffB[2];
#pragma unroll
    for (int i = 0; i < 2; ++i) { int R, C; stage_rc(tid * 16 + i * 8192, R, C); const int Rb = Epi::PERM ? ((R & ~31) + perm32(R & 31)) : R;
        voffA[i] = (unsigned)(R * K + C) * 2u; voffB[i] = (unsigned)(Rb * K + C) * 2u; }
    const size_t kstep = (size_t)(BK * 2);
    const size_t hstep = (size_t)HALF * K * 2;
    const size_t tstep = 2 * hstep;
    const unsigned ldsw = (unsigned)wid * 1024u;
    const int aoff = lds_byte(wr * 64 + fr, fq * 8), boff = lds_byte(wc * 32 + fr, fq * 8);
#define PG8_SA(b, h) (((b) * 2 + (h)) * HTB)
#define PG8_SB(b, h) ((4 + (b) * 2 + (h)) * HTB)
#define PG8_STAGE(bufoff, gbase, voff) do { _Pragma("unroll") for (int _i = 0; _i < 2; ++_i) { \
        if ((bufoff) >= 4 * HTB) __builtin_amdgcn_global_load_lds((const unsigned*)((const char*)(gbase) + (voff)[_i]), (PG8_LAS unsigned*)(lds + (bufoff) + ldsw + _i * 8192), 16, 0, PG8_AUX_B); \
        else __builtin_amdgcn_global_load_lds((const unsigned*)((const char*)(gbase) + (voff)[_i]), (PG8_LAS unsigned*)(lds + (bufoff) + ldsw + _i * 8192), 16, 0, PG8_AUX_A); } } while (0)
#define PG8_LDA(dst, b, h) do { _Pragma("unroll") for (int m = 0; m < 4; ++m) _Pragma("unroll") for (int k = 0; k < 2; ++k) dst[m][k] = *(const PG8_LAS bf16x8*)(lds + PG8_SA(b, h) + aoff + m * 2048 + k * 1024); } while (0)
#define PG8_LDB(dst, b, h) do { _Pragma("unroll") for (int n = 0; n < 2; ++n) _Pragma("unroll") for (int k = 0; k < 2; ++k) dst[n][k] = *(const PG8_LAS bf16x8*)(lds + PG8_SB(b, h) + boff + n * 2048 + k * 1024); } while (0)
#define PG8_MMA(ai, bj, At, Bt) do { __builtin_amdgcn_s_setprio(1); _Pragma("unroll") for (int m = 0; m < 4; ++m) _Pragma("unroll") for (int n = 0; n < 2; ++n) _Pragma("unroll") for (int k = 0; k < 2; ++k) \
        acc[ai][bj][m][n] = __builtin_amdgcn_mfma_f32_16x16x32_bf16(Bt[n][k], At[m][k], acc[ai][bj][m][n], 0, 0, 0); __builtin_amdgcn_s_setprio(0); } while (0)
#define PG8_WAIT_V(n) asm volatile("s_waitcnt vmcnt(" #n ")" ::: "memory")
#define PG8_WAIT_L(n) asm volatile("s_waitcnt lgkmcnt(" #n ")" ::: "memory")
#define PG8_BAR __builtin_amdgcn_s_barrier()
#define PG8_SCHED __builtin_amdgcn_sched_barrier(0)
    Unit cur, nxt; int ui = 0;
    if (!S.next(0, cur)) return;
    f32x4 acc[2][2][4][2];
#pragma unroll
    for (int a = 0; a < 2; ++a)
#pragma unroll
        for (int b = 0; b < 2; ++b)
#pragma unroll
            for (int m = 0; m < 4; ++m)
#pragma unroll
                for (int n = 0; n < 2; ++n) acc[a][b][m][n] = (f32x4){0.f, 0.f, 0.f, 0.f};
    if constexpr (Epi::INIT_ACC) E.init_acc(acc, cur, wr, wc, fr, fq);
    bf16x8 At[4][2], B0[2][2], B1[2][2];
    const char* cA = (const char*)g.A + (size_t)cur.pm * tstep; const char* cB = (const char*)g.Bt + (size_t)cur.pn * tstep;
    S.a_ready(cur);
    if constexpr (SP2) {
        PG8_STAGE(PG8_SB(0, 0), cB, voffB); PG8_STAGE(PG8_SB(0, 1), cB + hstep, voffB); PG8_STAGE(PG8_SA(0, 0), cA, voffA); PG8_STAGE(PG8_SA(0, 1), cA + hstep, voffA);
        if (wr == 1) PG8_BAR;
        PG8_WAIT_V(2); PG8_BAR;
        PG8_STAGE(PG8_SB(1, 0), cB + kstep, voffB); PG8_STAGE(PG8_SA(1, 0), cA + kstep, voffA); PG8_STAGE(PG8_SB(1, 1), cB + hstep + kstep, voffB);
        PG8_WAIT_V(6); PG8_BAR;
    } else {
        PG8_STAGE(PG8_SB(0, 0), cB, voffB); PG8_STAGE(PG8_SA(0, 0), cA, voffA); PG8_STAGE(PG8_SB(0, 1), cB + hstep, voffB); PG8_STAGE(PG8_SA(0, 1), cA + hstep, voffA);
        if (wr == 1) PG8_BAR;
        PG8_WAIT_V(4); PG8_BAR;
        PG8_STAGE(PG8_SB(1, 0), cB + kstep, voffB); PG8_STAGE(PG8_SA(1, 0), cA + kstep, voffA); PG8_STAGE(PG8_SB(1, 1), cB + hstep + kstep, voffB);
        PG8_WAIT_V(6); PG8_BAR;
    }
    for (;;) {
        const bool has_next = S.next(ui + 1, nxt);
        const char* nA = has_next ? (const char*)g.A + (size_t)nxt.pm * tstep : cA; const char* nB = has_next ? (const char*)g.Bt + (size_t)nxt.pn * tstep : cB;
        PG8_KSTAMP_BEGIN();
        for (int t = 0; t < nt; t += 2) {
            const bool last = (t == nt - 2);
            const char* a1 = cA + (size_t)(t + 1) * kstep;
            const char* a2 = last ? nA : cA + (size_t)(t + 2) * kstep; const char* b2 = last ? nB : cB + (size_t)(t + 2) * kstep;
            const char* a3 = a2 + kstep; const char* b3 = b2 + kstep;
            PG8_KSTAMP_TRIP();
            if (last && has_next) S.a_ready(nxt);
            if constexpr (Epi::MID_T >= 0) { if (t == E.mid_t()) E.mid(acc, cur, wr, wc, fr, fq); }
            if constexpr (SP2) {
            PG8_LDB(B0, 0, 0); PG8_LDB(B1, 0, 1); PG8_SCHED; PG8_LDA(At, 0, 0); PG8_STAGE(PG8_SA(1, 1), a1 + hstep, voffA);
            PG8_WAIT_V(8); PG8_WAIT_L(0); PG8_BAR; PG8_MMA(0, 0, At, B0); PG8_MMA(0, 1, At, B1); PG8_BAR; PG8_SCHED;
            PG8_LDA(At, 0, 1); PG8_STAGE(PG8_SB(0, 0), b2, voffB); PG8_STAGE(PG8_SB(0, 1), b2 + hstep, voffB); PG8_STAGE(PG8_SA(0, 0), a2, voffA);
            PG8_WAIT_V(8); PG8_WAIT_L(0); PG8_BAR; PG8_MMA(1, 0, At, B0); PG8_MMA(1, 1, At, B1); PG8_BAR; PG8_SCHED;
            PG8_LDB(B0, 1, 0); PG8_LDB(B1, 1, 1); PG8_SCHED; PG8_LDA(At, 1, 0); PG8_STAGE(PG8_SA(0, 1), a2 + hstep, voffA);
            PG8_WAIT_V(8); PG8_WAIT_L(0); PG8_BAR; PG8_MMA(0, 0, At, B0); PG8_MMA(0, 1, At, B1); PG8_BAR; PG8_SCHED;
            PG8_LDA(At, 1, 1); PG8_STAGE(PG8_SB(1, 0), b3, voffB); PG8_STAGE(PG8_SB(1, 1), b3 + hstep, voffB); PG8_STAGE(PG8_SA(1, 0), a3, voffA);
            PG8_WAIT_V(8); PG8_WAIT_L(0); PG8_BAR; PG8_MMA(1, 0, At, B0); PG8_MMA(1, 1, At, B1); PG8_BAR; PG8_SCHED;
            } else {
            PG8_LDB(B0, 0, 0); PG8_SCHED; PG8_LDA(At, 0, 0); PG8_STAGE(PG8_SA(1, 1), a1 + hstep, voffA);
            PG8_WAIT_L(8); PG8_BAR; PG8_WAIT_L(0); PG8_MMA(0, 0, At, B0); PG8_BAR; PG8_SCHED;
            PG8_LDB(B1, 0, 1); PG8_STAGE(PG8_SB(0, 0), b2, voffB);
            PG8_BAR; PG8_WAIT_L(0); PG8_MMA(0, 1, At, B1); PG8_BAR;
            PG8_LDA(At, 0, 1); PG8_STAGE(PG8_SA(0, 0), a2, voffA);
            PG8_BAR; PG8_WAIT_L(0); PG8_MMA(1, 0, At, B0); PG8_BAR; PG8_SCHED;
            PG8_STAGE(PG8_SB(0, 1), b2 + hstep, voffB);
            PG8_WAIT_V(6); PG8_BAR; PG8_MMA(1, 1, At, B1); PG8_BAR;
            PG8_LDB(B0, 1, 0); PG8_SCHED; PG8_LDA(At, 1, 0); PG8_STAGE(PG8_SA(0, 1), a2 + hstep, voffA);
            PG8_WAIT_L(8); PG8_BAR; PG8_WAIT_L(0); PG8_MMA(0, 0, At, B0); PG8_BAR; PG8_SCHED;
            PG8_LDB(B1, 1, 1); PG8_STAGE(PG8_SB(1, 0), b3, voffB);
            PG8_BAR; PG8_WAIT_L(0); PG8_MMA(0, 1, At, B1); PG8_BAR;
            PG8_LDA(At, 1, 1); PG8_STAGE(PG8_SA(1, 0), a3, voffA);
            PG8_BAR; PG8_WAIT_L(0); PG8_MMA(1, 0, At, B0); PG8_BAR; PG8_SCHED;
            PG8_STAGE(PG8_SB(1, 1), b3 + hstep, voffB);
            PG8_WAIT_V(6); PG8_BAR; PG8_MMA(1, 1, At, B1); PG8_BAR;
            }
        }
        PG8_KSTAMP_END();
        if constexpr (ALIGN_EPI) { if (wr == 0) PG8_BAR; }
        if constexpr (!Epi::AFTER_DRAIN) { E(acc, cur, wr, wc, fr, fq); S.done(cur); }
        if (!has_next) break;
#pragma unroll
        for (int a = 0; a < 2; ++a)
#pragma unroll
            for (int b = 0; b < 2; ++b)
#pragma unroll
                for (int m = 0; m < 4; ++m)
#pragma unroll
                    for (int n = 0; n < 2; ++n) acc[a][b][m][n] = (f32x4){0.f, 0.f, 0.f, 0.f};
        cur = nxt; cA = nA; cB = nB; ++ui;
        if constexpr (ALIGN_EPI) { if (wr == 1) PG8_BAR; }
    }
    PG8_WAIT_V(0);
    if constexpr (!ALIGN_EPI) { if (wr == 0) PG8_BAR; }
    PG8_BAR;
    if constexpr (Epi::AFTER_DRAIN) { E.fused(acc, cur, wr, wc, fr, fq, lds, wid, lane); S.done(cur); }
#undef PG8_SA
#undef PG8_SB
#undef PG8_STAGE
#undef PG8_LDA
#undef PG8_LDB
#undef PG8_MMA
#undef PG8_WAIT_V
#undef PG8_WAIT_L
#undef PG8_BAR
#undef PG8_SCHED
}
}
#ifdef MK_STAMP_A
#define ATT_SUBSTAMP() do { if (tid == 0) ((ATT_LAS unsigned*)(lds + (155648 - 1024) + 64))[att_ns] = (unsigned)__builtin_amdgcn_s_memrealtime(); ++att_ns; } while (0)
#endif
#ifndef ATT_KVLD
#define ATT_KVLD(p) (*(p))
#endif
#ifndef ATT_SUBSTAMP
#define ATT_SUBSTAMP() do {} while (0)
#endif
namespace att {
typedef unsigned short bf16_t;
typedef short bf16x8 __attribute__((ext_vector_type(8)));
typedef short s16x4 __attribute__((ext_vector_type(4)));
typedef float f32x16 __attribute__((ext_vector_type(16)));
typedef float f32x2_t __attribute__((ext_vector_type(2)));
typedef __bf16 bf16x2_t __attribute__((ext_vector_type(2)));
typedef unsigned u32x4 __attribute__((ext_vector_type(4)));
typedef unsigned u32x2 __attribute__((ext_vector_type(2)));
#define ATT_LAS __attribute__((address_space(3)))
constexpr int T = 8192;
constexpr float LOG2E = 1.4426950408889634f;
constexpr float NEG_BIG = -1.0e30f;
constexpr int B_K = 0, B_VT = 49152, B_VT_PITCH = 784, B_TAB = B_VT + 64 * B_VT_PITCH  , B_TAB_N = 320;
constexpr int MISC = B_TAB + 4 * B_TAB_N * 4;
constexpr int A_TAB = MISC + 64;
constexpr int O_STAGE = A_TAB + 8192, O_STAGE_PITCH = 144, O_STAGE_WAVE = 32 * O_STAGE_PITCH;
static_assert(A_TAB % 16 == 0 && O_STAGE % 16 == 0, "attention LDS map");
__device__ __forceinline__ int kappa(int r) { return (r & 19) | ((r & 4) << 1) | ((r & 8) >> 1); }
__device__ __forceinline__ int kcol0(int i) { return (i & 7) + 16 * (i >> 3); }
__device__ __forceinline__ int crow(int i, int h) { return (i & 3) + 8 * (i >> 2) + 4 * h; }
__device__ __forceinline__ unsigned cvtpk(float lo, float hi) { f32x2_t v = {lo, hi}; bf16x2_t b = __builtin_convertvector(v, bf16x2_t); return __builtin_bit_cast(unsigned, b); }
__device__ __forceinline__ bf16x8 pack8(const float* e) { u32x4 p; p.x = cvtpk(e[0], e[1]); p.y = cvtpk(e[2], e[3]); p.z = cvtpk(e[4], e[5]); p.w = cvtpk(e[6], e[7]); return __builtin_bit_cast(bf16x8, p); }
__device__ __forceinline__ bf16x8 cat4(s16x4 a, s16x4 b) { return (bf16x8){a[0], a[1], a[2], a[3], b[0], b[1], b[2], b[3]}; }
__device__ __forceinline__ int clampi(int v, int lo, int hi) { return v < lo ? lo : (v > hi ? hi : v); }
__device__ __forceinline__ float wave_max(float v) {
#pragma unroll
    for (int o = 1; o < 64; o <<= 1) v = fmaxf(v, __shfl_xor(v, o));
    return v;
}
#define ATT_MFMA(a, b, c) __builtin_amdgcn_mfma_f32_32x32x16_bf16((a), (b), (c), 0, 0, 0)

struct Tensors {
    const bf16_t *QA, *KA, *VAT, *QB, *KB, *VBT; bf16_t *OA, *OB;
    const float *rpb, *qna, *kna, *qnb, *knb, *sink, *t5;
};

__device__ __forceinline__ int t5_bucket(int rel) {
    const int n = rel < 0 ? -rel : rel;
    const int large = 8 + (n >= 12) + (n >= 16) + (n >= 23) + (n >= 32) + (n >= 46) + (n >= 64) + (n >= 91);
    return (rel > 0 ? 16 : 0) + (n < 8 ? n : large);
}

template <class TokF> __device__ __forceinline__ void store_o(ATT_LAS unsigned char* stg, bf16_t* obase  , TokF tok, const f32x16& o0, const f32x16& o1, float il, int lane) {
    const int r = lane & 31, hi = lane >> 5;
#pragma unroll
    for (int g = 0; g < 4; ++g) {
        u32x2 w0, w1;
        w0.x = cvtpk(o0[4 * g] * il, o0[4 * g + 1] * il); w0.y = cvtpk(o0[4 * g + 2] * il, o0[4 * g + 3] * il);
        w1.x = cvtpk(o1[4 * g] * il, o1[4 * g + 1] * il); w1.y = cvtpk(o1[4 * g + 2] * il, o1[4 * g + 3] * il);
        *(ATT_LAS u32x2*)(stg + r * O_STAGE_PITCH + (8 * g + 4 * hi) * 2) = w0; *(ATT_LAS u32x2*)(stg + r * O_STAGE_PITCH + 64 + (8 * g + 4 * hi) * 2) = w1;
    }
#pragma unroll
    for (int i = 0; i < 4; ++i) { const int q = (lane >> 3) + 8 * i, c = lane & 7;
        const u32x4 v = *(const ATT_LAS u32x4*)(stg + q * O_STAGE_PITCH + c * 16);
        *(u32x4*)(obase + (size_t)tok(q) * 1024 + c * 8) = v; }
}

__device__ __forceinline__ void natten_quad(const Tensors& A, const ATT_LAS float* tab  , ATT_LAS unsigned char* stg  , int b, int h, int j, int v, int lane) {
    const int r = lane & 31, hi = lane >> 5;
    const int R0 = 4 * v, qc = 16 * j + (r & 15);
    const int kr_lo = clampi(R0 - 4, 0, 120), kr_hi = clampi(R0 - 1, 0, 120) + 7, nrows = kr_hi - kr_lo + 1;
    const int ss = clampi(16 * j - 8, 0, 32), ws = clampi(qc - 8, 0, 48);
    const int qrow0 = R0 + (r >> 4), qrow1 = R0 + 2 + (r >> 4);
    const int rsq0 = clampi(qrow0 - 4, 0, 120), rsq1 = clampi(qrow1 - 4, 0, 120);
    const int lo0 = clampi(R0 - 4, 0, 120), hi0 = clampi(R0 - 3, 0, 120) + 8, lo1 = clampi(R0 - 2, 0, 120), hi1 = clampi(R0 - 1, 0, 120) + 8;
    const size_t mq0 = (size_t)b * T + qrow0 * 64 + qc, mq1 = mq0 + 128;
    bf16x8 qf0[4], qf1[4];
#pragma unroll
    for (int s = 0; s < 4; ++s) { qf0[s] = __builtin_nontemporal_load((const bf16x8*)(A.QA + mq0 * 512 + h * 64 + 16 * s + 8 * hi));
                                  qf1[s] = __builtin_nontemporal_load((const bf16x8*)(A.QA + mq1 * 512 + h * 64 + 16 * s + 8 * hi)); }
    f32x16 oa0, oa1, ob0, ob1;
#pragma unroll
    for (int i = 0; i < 16; ++i) { oa0[i] = 0.f; oa1[i] = 0.f; ob0[i] = 0.f; ob1[i] = 0.f; }
    float lsa = 0.f, lsb = 0.f;
    const int cmask0 = ss + 8 * hi - ws;
    const int dcol0 = ss + 8 * hi - qc + 31;
    const int tk0 = kr_lo * 64 + ss + kappa(r);
    const bf16_t* kbase = A.KA + ((size_t)(b * 1024 * 8 + h) * 64 + hi * 8 + (tk0 & 7)) * 8 + (size_t)(tk0 >> 3) * (8 * 512);
    const bf16_t* vbase = A.VAT + ((size_t)(b * 1024 * 8 + h) * 64 + r) * 8 + (size_t)((kr_lo * 64 + ss + 8 * hi) >> 3) * (8 * 512);
    bf16x8 kf[4], vf[4], kn[4], vn[4];
#define ATT_LOADKV(KF, VF, kr_) do { const size_t ko_ = (size_t)(kr_) * (8 * 8 * 512); \
        _Pragma("unroll") for (int s = 0; s < 4; ++s) KF[s] = ATT_KVLD((const bf16x8*)(kbase + ko_ + s * 128)); \
        _Pragma("unroll") for (int dt = 0; dt < 2; ++dt) _Pragma("unroll") for (int s2 = 0; s2 < 2; ++s2) VF[dt * 2 + s2] = ATT_KVLD((const bf16x8*)(vbase + ko_ + dt * 256 + s2 * (2 * 8 * 512))); } while (0)
#define ATT_BLOCK(QF, O0, O1, LS, QROW, RSQ) do { \
        const bool rowok = (krow >= (RSQ)) && (krow < (RSQ) + 8); \
        const ATT_LAS float* tp = tab + (rowok ? (krow - (QROW) + 7) : 15) * 64 + dcol0; \
        float bv[16]; _Pragma("unroll") for (int i = 0; i < 16; ++i) bv[i] = tp[kcol0(i)]; \
        f32x16 x; _Pragma("unroll") for (int i = 0; i < 16; ++i) x[i] = 0.f; \
        _Pragma("unroll") for (int s = 0; s < 4; ++s) x = ATT_MFMA(kf[s], QF[s], x); \
        float e[16]; \
        _Pragma("unroll") for (int i = 0; i < 16; ++i) { const float v_ = __builtin_amdgcn_exp2f(x[i] + bv[i]); e[i] = ((unsigned)(cmask0 + kcol0(i)) < 16u) ? v_ : 0.f; LS += e[i]; } \
        _Pragma("unroll") for (int s2 = 0; s2 < 2; ++s2) { const bf16x8 xs = pack8(e + 8 * s2); O0 = ATT_MFMA(vf[s2], xs, O0); O1 = ATT_MFMA(vf[2 + s2], xs, O1); } } while (0)
    ATT_LOADKV(kf, vf, 0);
    for (int kr = 0; kr < nrows; ++kr) {
        const int krow = kr_lo + kr;
        if (kr + 1 < nrows) ATT_LOADKV(kn, vn, kr + 1);
        if (krow >= lo0 && krow < hi0) ATT_BLOCK(qf0, oa0, oa1, lsa, qrow0, rsq0);
        if (krow >= lo1 && krow < hi1) ATT_BLOCK(qf1, ob0, ob1, lsb, qrow1, rsq1);
#pragma unroll
        for (int s = 0; s < 4; ++s) { kf[s] = kn[s]; vf[s] = vn[s]; }
    }
#undef ATT_LOADKV
#undef ATT_BLOCK
    lsa += __shfl_xor(lsa, 32); lsb += __shfl_xor(lsb, 32);
    { const size_t tb0 = (size_t)b * T + R0 * 64 + 16 * j;
      store_o(stg, A.OA + h * 64, [&](int q) { return tb0 + (q >> 4) * 64 + (q & 15); }, oa0, oa1, 1.0f / lsa, lane);
      store_o(stg, A.OA + h * 64, [&](int q) { return tb0 + 128 + (q >> 4) * 64 + (q & 15); }, ob0, ob1, 1.0f / lsb, lane); }
}

__device__ __forceinline__ void swa_stage(ATT_LAS unsigned char* lds, const Tensors& A, int b, int n, int kvh, int tid) {
#pragma unroll
    for (int i = 0; i < 6; ++i) { const int c = tid + 512 * i, tbw = c >> 6, ch = (c >> 3) & 7, ti = c & 7, w = tbw * 8 + ti; const int tok = clampi(n * 128 - 128 + w, 0, T - 1);
        const u32x4 v = *(const u32x4*)(A.KB + ((size_t)((b * 1024 + (tok >> 3)) * 2 + kvh) * 64 + ch * 8 + (tok & 7)) * 8);
        *(ATT_LAS u32x4*)(lds + B_K + w * 128 + ((ch ^ ((w >> 1) & 7)) << 4)) = v; }
#pragma unroll
    for (int i = 0; i < 6; ++i) { const int c = tid + 512 * i, tbw = c >> 6, d = c & 63; const int tb = n * 16 - 16 + tbw;
        u32x4 v = (u32x4){0u, 0u, 0u, 0u};
        if (tb >= 0 && tb < T / 8) v = *(const u32x4*)(A.VBT + ((size_t)((b * 1024 + tb) * 2 + kvh) * 64 + d) * 8);
        *(ATT_LAS u32x4*)(lds + B_VT + d * B_VT_PITCH + tbw * 16) = v; }
}
__device__ __forceinline__ void swa_compute(ATT_LAS unsigned char* lds, ATT_LAS unsigned char* stg  , const Tensors& A, int b, int n, int kvh, int g, int sb0, int lane) {
    const ATT_LAS float* misc = (const ATT_LAS float*)(lds + MISC);
    const int head = kvh * 4 + g, r = lane & 31, hi = lane >> 5;
    const ATT_LAS float* tabg = (const ATT_LAS float*)(lds + B_TAB) + g * B_TAB_N;
    const int kap = kappa(r), kswz = (kap >> 1) & 7;
#pragma unroll 1
    for (int sb = sb0; sb < sb0 + 2; ++sb) {
        const size_t mq = (size_t)b * T + n * 128 + 32 * sb + r;
        bf16x8 qf[4];
#pragma unroll
        for (int s = 0; s < 4; ++s) qf[s] = __builtin_nontemporal_load((const bf16x8*)(A.QB + mq * 512 + head * 64 + 16 * s + 8 * hi));
        f32x16 o0, o1;
#pragma unroll
        for (int i = 0; i < 16; ++i) { o0[i] = 0.f; o1[i] = 0.f; }
        float lsum = 0.f;
        const int kt_lo = sb > ((n == 0) ? 4 : 0) ? sb : ((n == 0) ? 4 : 0);
        const int kt_hi = (sb + 8) < ((n == T / 128 - 1) ? 7 : 11) ? (sb + 8) : ((n == T / 128 - 1) ? 7 : 11);
        for (int kt = kt_lo; kt <= kt_hi; ++kt) {
            const ATT_LAS float* tp = tabg + 32 * (kt - sb) + 32 - r + 8 * hi;
            const ATT_LAS unsigned char* kp = lds + B_K + (32 * kt + kap) * 128;
            bf16x8 kf[4];
#pragma unroll
            for (int s = 0; s < 4; ++s) kf[s] = *(const ATT_LAS bf16x8*)(kp + (((2 * s + hi) ^ kswz) << 4));
            float bv[16];
#pragma unroll
            for (int i = 0; i < 16; ++i) bv[i] = tp[kcol0(i)];
            f32x16 x;
#pragma unroll
            for (int i = 0; i < 16; ++i) x[i] = 0.f;
#pragma unroll
            for (int s = 0; s < 4; ++s) x = ATT_MFMA(kf[s], qf[s], x);
            float e[16];
#pragma unroll
            for (int i = 0; i < 16; ++i) { e[i] = __builtin_amdgcn_exp2f(x[i] + bv[i]); lsum += e[i]; }
            const ATT_LAS unsigned char* vp = lds + B_VT + r * B_VT_PITCH + (32 * kt + 8 * hi) * 2;
#pragma unroll
            for (int s2 = 0; s2 < 2; ++s2) { const bf16x8 xs = pack8(e + 8 * s2);
                const bf16x8 a0 = *(const ATT_LAS bf16x8*)(vp + 32 * s2), c0 = *(const ATT_LAS bf16x8*)(vp + 32 * B_VT_PITCH + 32 * s2);
                o0 = ATT_MFMA(a0, xs, o0); o1 = ATT_MFMA(c0, xs, o1); }
        }
        lsum += __shfl_xor(lsum, 32);
        lsum += misc[12 + g];
        { const size_t tb0 = (size_t)b * T + n * 128 + 32 * sb; store_o(stg, A.OB + head * 64, [&](int q) { return tb0 + q; }, o0, o1, 1.0f / lsum, lane); }
    }
}

constexpr int TAB_A_FLOATS = 8 * 16 * 64, TAB_B_FLOATS = 8 * B_TAB_N, TAB_FLOATS = TAB_A_FLOATS + TAB_B_FLOATS + 8;
__device__ __forceinline__ void build_tables(ATT_LAS unsigned char* lds, float* tabs, const Tensors& A, int h, int tid, int wid, int lane) {
    ATT_LAS float* misc = (ATT_LAS float*)lds;
    if (wid == 0) { float mx = 0.f;
        for (int i = lane; i < 15 * 31; i += 64) mx = fmaxf(mx, fabsf(A.rpb[i * 8 + h]));
        mx = wave_max(mx); const float gq = wave_max(fabsf(A.qna[lane])), gk = wave_max(fabsf(A.kna[lane]));
        if (lane == 0) misc[0] = 8.0f * gq * gk * 1.02f + mx;
    } else if (wid == 1) { float mx = lane < 32 ? fabsf(A.t5[lane * 8 + h]) : 0.f;
        mx = wave_max(mx); const float gq = wave_max(fabsf(A.qnb[lane])), gk = wave_max(fabsf(A.knb[lane]));
        const float sk = A.sink[h], M = fmaxf(8.0f * gq * gk * 1.02f + mx, sk);
        if (lane == 0) { misc[1] = M; tabs[TAB_A_FLOATS + TAB_B_FLOATS + h] = __builtin_amdgcn_exp2f((sk - M) * LOG2E); }
    }
    __syncthreads();
    for (int idx = tid; idx < 16 * 64; idx += 512) { const int row = idx >> 6, dc = (idx & 63) - 16; float v = NEG_BIG;
        if (row < 15 && dc >= 0 && dc <= 30) v = (A.rpb[(row * 31 + dc) * 8 + h] - misc[0]) * LOG2E;
        tabs[h * 1024 + idx] = v; }
    for (int idx = tid; idx < B_TAB_N; idx += 512) { const int rel = idx - 160; float v = NEG_BIG;
        if (rel >= -128 && rel <= 128) v = (A.t5[t5_bucket(rel) * 8 + h] - misc[1]) * LOG2E;
        tabs[TAB_A_FLOATS + h * B_TAB_N + idx] = v; }
    __syncthreads();
}

__device__ __forceinline__ void attn_phase(ATT_LAS unsigned char* lds, const Tensors& A, const float* tabs, int vcu, int tid, int wid, int lane) {
    int att_ns = 0; (void)att_ns;
    ATT_LAS float* misc = (ATT_LAS float*)(lds + MISC);
    const int b = vcu >> 7, v = (vcu & 127) >> 2, hp = vcu & 3, n = 2 * v + (hp & 1), kvh = hp >> 1;
    {
        ((ATT_LAS u32x4*)(lds + A_TAB))[tid] = ((const u32x4*)(tabs + 2 * hp * 1024))[tid];
        if (tid < B_TAB_N) ((ATT_LAS u32x4*)(lds + B_TAB))[tid] = ((const u32x4*)(tabs + TAB_A_FLOATS + 4 * kvh * B_TAB_N))[tid];
        if (tid < 4) misc[12 + tid] = tabs[TAB_A_FLOATS + TAB_B_FLOATS + 4 * kvh + tid];
    }
    swa_stage(lds, A, b, n, kvh, tid);
    __syncthreads();
    ATT_SUBSTAMP();
    natten_quad(A, (const ATT_LAS float*)(lds + A_TAB) + (wid & 1) * 1024, lds + O_STAGE + wid * O_STAGE_WAVE, b, 2 * hp + (wid & 1), wid >> 1, v, lane);
    ATT_SUBSTAMP();
    swa_compute(lds, lds + O_STAGE + wid * O_STAGE_WAVE, A, b, n, kvh, wid & 3, 2 * (wid >> 2), lane);
    __syncthreads();
}
}

#ifndef PG8_SP2
#define PG8_SP2 true
#endif
#ifndef PG8_ALIGN
#define PG8_ALIGN true
#endif

#ifndef MK_REPEAT
#define MK_REPEAT (-1)
#endif
#ifndef MK_BF16_RESID
#define MK_BF16_RESID 1
#endif
#ifndef MK_CODE_PREFETCH
#define MK_CODE_PREFETCH 0
#endif
#define MK_CODE_BYTES 94208
#ifndef MK_WGM_P1
#define MK_WGM_P1 4
#endif
#ifndef MK_WGM_P5
#define MK_WGM_P5 4
#endif
#ifndef MK_HOOK4
#define MK_HOOK4(v) (2 + 2 * ((v) % 6))
#endif
#ifndef MK_HOOK6
#define MK_HOOK6(v) (2 + 2 * ((v) % 20))
#endif
#ifndef MK_GROUP_BAR
#define MK_GROUP_BAR 1
#endif
constexpr int NWAVES = 8;
constexpr int N_PHASES = 7;
constexpr int BATCH = 2, T = 8192, D = 1024, M = BATCH * T, FF = 2816, NIN = 4352, AW = 512;
constexpr size_t MiB = 1u << 20;
constexpr size_t WS_CTL = 0, CTL_ZERO_BYTES = 1 * MiB;
constexpr size_t WS_WIN = 1 * MiB;
constexpr size_t WS_WB = WS_WIN + (size_t)NIN * D * 2;
constexpr size_t WS_WO = WS_WB + (size_t)D * D * 2;
constexpr size_t WS_WGU = WS_WO + (size_t)D * D * 2;
constexpr size_t WS_WD = WS_WGU + (size_t)2 * FF * D * 2;
constexpr size_t WS_WEND = WS_WD + (size_t)D * FF * 2;
constexpr size_t WS_RS1 = 30 * MiB, WS_SS = 30 * MiB + 512 * 1024;
constexpr size_t WS_TABS = 31 * MiB;
constexpr size_t WS_XN = 32 * MiB;
constexpr size_t WS_Y = WS_XN;
constexpr size_t WS_QA = 64 * MiB, WS_KA = 80 * MiB, WS_VAT = 96 * MiB, WS_QB = 112 * MiB, WS_KB = 128 * MiB, WS_VBT = 132 * MiB;
constexpr size_t WS_GATE = 136 * MiB;
constexpr size_t WS_OA = 200 * MiB, WS_OB = WS_OA + 512 * 2;
constexpr size_t WS_X1B = WS_OA;
constexpr size_t WS_U = 64 * MiB;
constexpr size_t WS_END = 256 * MiB;
static_assert(WS_WEND <= WS_RS1 && WS_SS + (size_t)M * 16 <= WS_XN && WS_U + (size_t)M * FF * 2 <= WS_OA && WS_OA + (size_t)M * D * 2 <= WS_END, "d_ws map");
constexpr int CW_TMO = 0, CW_CODE = 1, CW_BAR = 4096, CW_GRP = 12288, CW_XCC = 8192;

constexpr int RING_OFF = 0, RING_BYTES = 131072;
constexpr int LDS_BYTES = 155648;
constexpr int LDSCTL_OFF = LDS_BYTES - 1024, MISC_OFF = LDSCTL_OFF + 320;
constexpr int EPI_TAB_OFF = RING_BYTES;
static_assert(MISC_OFF + 128 <= LDS_BYTES && EPI_TAB_OFF + 8192 <= LDSCTL_OFF && att::O_STAGE + 8 * att::O_STAGE_WAVE <= LDSCTL_OFF, "LDS map");

#define GAS __attribute__((address_space(1)))
#define LAS __attribute__((address_space(3)))
typedef unsigned short bf16;
typedef unsigned v4u __attribute__((ext_vector_type(4)));
typedef float f32x4 __attribute__((ext_vector_type(4)));
typedef short bf16x8 __attribute__((ext_vector_type(8)));
typedef GAS unsigned gu32;
typedef GAS unsigned long long gu64;
#define RLX_AGENT __ATOMIC_RELAXED, __HIP_MEMORY_SCOPE_AGENT
#define LDS_WAIT() asm volatile("s_waitcnt lgkmcnt(0)" ::: "memory")
#define VM_WAIT() asm volatile("s_waitcnt vmcnt(0)" ::: "memory")
__device__ __forceinline__ unsigned long long rt() { return __builtin_amdgcn_s_memrealtime(); }
__device__ __forceinline__ unsigned f2bf(float f) { unsigned u = __builtin_bit_cast(unsigned, f); return (u + 0x7fffu + ((u >> 16) & 1u)) >> 16; }
__device__ __forceinline__ unsigned pk2(float lo, float hi) { return f2bf(lo) | (f2bf(hi) << 16); }
#define XB_TMO      128
#define XB_XCNT(j)  (256  + 64 * (j))
#define XB_XSUB(j)  (1280 + 64 * (j))
#define XB_XGEN(j)  (2304 + 64 * (j))
#define XB_TOP      3328
#define XB_TOPGEN   3392
#define XCD_BAR_WORDS 3456
#define XB_SPIN_CAP (1u << 18)

__device__ __forceinline__ unsigned xb_ld(unsigned* p)              { return __hip_atomic_load(p, __ATOMIC_RELAXED, __HIP_MEMORY_SCOPE_AGENT); }
__device__ __forceinline__ unsigned xb_add(unsigned* p, unsigned v) { return __hip_atomic_fetch_add(p, v, __ATOMIC_RELAXED, __HIP_MEMORY_SCOPE_AGENT); }
__device__ __forceinline__ unsigned xb_xcc_id() { return (unsigned)__builtin_amdgcn_s_getreg((3 << 11) | 20) & 0xFu; }
#define XB_SPIN(cond, bar) do { unsigned _sp = 0; while (cond) { __builtin_amdgcn_s_sleep(1); \
    if ((++_sp & 255u) == 0u) { if (xb_ld(&(bar)[XB_TMO])) break; if (_sp > XB_SPIN_CAP) { atomicAdd(&(bar)[XB_TMO], 1u); break; } } } } while (0)

struct XcdBarrier {
    unsigned* bar; unsigned x;
    volatile LAS unsigned* st;
};

__device__ __forceinline__ XcdBarrier xcd_barrier_post(unsigned* bar, volatile LAS unsigned* st) {
    XcdBarrier b; b.bar = bar; b.x = xb_xcc_id(); b.st = st;
    if (threadIdx.x == 0) (void)xb_add(&bar[XB_XCNT(b.x)], 1u);
    return b;
}
__device__ __forceinline__ void xcd_barrier_complete(unsigned* bar, unsigned x, unsigned& nloc, unsigned& nx) {
    const unsigned G = gridDim.x * gridDim.y * gridDim.z;
    unsigned sum, cnt, mine, sp = 0u;
    for (;;) {
        sum = 0u; cnt = 0u; mine = 0u;
#pragma unroll
        for (unsigned j = 0; j < 16; ++j) { const unsigned c = xb_ld(&bar[XB_XCNT(j)]); sum += c; cnt += (c > 0u) ? 1u : 0u; mine = (j == x) ? c : mine; }
        if (sum == G) break;
        __builtin_amdgcn_s_sleep(1);
        if ((++sp & 255u) == 0u) { if (xb_ld(&bar[XB_TMO])) break; if (sp > XB_SPIN_CAP) { atomicAdd(&bar[XB_TMO], 1u); break; } }
    }
    nloc = mine > 0u ? mine : 1u; nx = cnt > 0u ? cnt : 1u;
}

__device__ __forceinline__ void xcd_barrier(const XcdBarrier& b) {
    asm volatile("s_waitcnt vmcnt(0)" ::: "memory");
    __syncthreads();
    if (threadIdx.x == 0) {
        unsigned* bar = b.bar;
        __builtin_amdgcn_s_waitcnt(0);
        unsigned nloc = b.st[0], nx = b.st[1];
        if (nloc == 0u) { xcd_barrier_complete(bar, b.x, nloc, nx); b.st[0] = nloc; b.st[1] = nx; }
        const unsigned old = xb_add(&bar[XB_XSUB(b.x)], 1u);
        const unsigned gen = old / nloc;
        if (old + 1u == (gen + 1u) * nloc) {
            __builtin_amdgcn_fence(__ATOMIC_RELEASE, "agent");
            asm volatile("s_waitcnt vmcnt(0)" ::: "memory");
            const unsigned og = xb_add(&bar[XB_TOP], 1u);
            const unsigned tg = og / nx;
            if (og + 1u == (tg + 1u) * nx) xb_add(&bar[XB_TOPGEN], 1u);
            else XB_SPIN(xb_ld(&bar[XB_TOPGEN]) == tg, bar);
            __builtin_amdgcn_fence(__ATOMIC_ACQUIRE, "agent");
            xb_add(&bar[XB_XGEN(b.x)], 1u);
            asm volatile("s_waitcnt vmcnt(0)" ::: "memory");
        } else {
            XB_SPIN(xb_ld(&bar[XB_XGEN(b.x)]) == gen, bar);
            __builtin_amdgcn_fence(__ATOMIC_ACQUIRE, "agent");
            asm volatile("s_waitcnt vmcnt(0)" ::: "memory");
        }
    }
    __syncthreads();
}


__device__ __forceinline__ void group_barrier(gu32* cnt, unsigned target, gu32* tmo) {
    asm volatile("s_waitcnt vmcnt(0)" ::: "memory");
    __syncthreads();
    if (threadIdx.x == 0) {
        (void)__hip_atomic_fetch_add(cnt, 1u, RLX_AGENT);
        unsigned sp = 0u;
        while (__hip_atomic_load(cnt, RLX_AGENT) < target) { __builtin_amdgcn_s_sleep(1);
            if ((++sp & 255u) == 0u) { if (__hip_atomic_load(tmo, RLX_AGENT)) break; if (sp > (1u << 18)) { __hip_atomic_store(tmo, 1u, RLX_AGENT); break; } } }
        __builtin_amdgcn_fence(__ATOMIC_ACQUIRE, "agent");
        asm volatile("s_waitcnt vmcnt(0)" ::: "memory");
    }
    __syncthreads();
}

struct Frame {
    LAS unsigned char* lds; volatile LAS unsigned* MISC; gu32* ctl;
    int tid, lane, wave, vcu, G;
};
struct Args { const float* in[17]; float* out; unsigned char* ws; int ph_lo, ph_hi; };
static_assert(sizeof(Args) == 17 * 8 + 8 + 8 + 8, "Args has no padding");

__device__ __forceinline__ float wave_sum(float v) {
#pragma unroll
    for (int o = 1; o < 64; o <<= 1) v += __shfl_xor(v, o);
    return v;
}
__device__ __forceinline__ const float* OPQ(const float* p) { asm volatile("" : "+s"(p)); return p; }
struct P0Item { const float* W; bf16* WT; const float* kscale; int ldk, N, k0, n0, drow0, kofs; };
__device__ __forceinline__ void p0_item_load(const P0Item& it, f32x4 (&v)[8], int lane) {
    const float* wp = it.W + (size_t)(it.k0 + (lane >> 3)) * it.N + it.n0 + 4 * (lane & 7);
#pragma unroll
    for (int i = 0; i < 8; ++i) v[i] = __builtin_nontemporal_load((const GAS f32x4*)(wp + (size_t)(8 * i) * it.N));
    if (it.kscale) {
#pragma unroll
        for (int i = 0; i < 8; ++i) v[i] = v[i] * it.kscale[it.k0 + (lane >> 3) + 8 * i];
    }
}
__device__ __forceinline__ void p0_item_finish(const P0Item& it, const f32x4 (&v)[8], LAS float* scr, int lane) {
#pragma unroll
    for (int i = 0; i < 8; ++i) { LAS float* d = scr + ((lane >> 3) + 8 * i) * 33 + 4 * (lane & 7); d[0] = v[i].x; d[1] = v[i].y; d[2] = v[i].z; d[3] = v[i].w; }
    LDS_WAIT(); asm volatile("" ::: "memory");
    const int c = lane & 7;
#pragma unroll
    for (int j = 0; j < 4; ++j) { const int n = (lane >> 3) + 8 * j; const LAS float* s = scr + (8 * c) * 33 + n;
        v4u o; o.x = pk2(s[0 * 33], s[1 * 33]); o.y = pk2(s[2 * 33], s[3 * 33]); o.z = pk2(s[4 * 33], s[5 * 33]); o.w = pk2(s[6 * 33], s[7 * 33]);
        *(GAS v4u*)(it.WT + (size_t)(it.drow0 + n) * it.ldk + it.kofs + it.k0 + 8 * c) = o; }
    LDS_WAIT(); asm volatile("" ::: "memory");
}
__device__ __forceinline__ P0Item p0_decode(const Args& a, int r) {
    unsigned char* ws = a.ws; P0Item it; it.kofs = 0; it.kscale = nullptr;
    constexpr int I_IN = (D / 64) * (NIN / 32), I_BR = (AW / 64) * (D / 32), I_O = (D / 64) * (D / 32), I_GU = (D / 64) * (FF / 32);
    if (r < I_IN) { const int nblk = NIN / 32, kb = r / nblk, nb = r % nblk, n0 = 32 * nb;
        const int within = n0 & 255; int drow0 = (n0 & ~255) + 128 * ((within >> 5) & 1) + 32 * (within >> 6);
        if (n0 >= 2304) { const int gb = n0 >= 3328 ? 1 : 0, c = n0 - 2304 - 1024 * gb; drow0 = 256 * (9 + (c >> 7)) + 128 * gb + (c & 127); }
        it.W = OPQ(a.in[2]); it.WT = (bf16*)(ws + WS_WIN); it.ldk = D; it.N = NIN; it.k0 = 64 * kb; it.n0 = n0; it.drow0 = drow0; return it; } r -= I_IN;
    if (r < 2 * I_BR) { const int second = r >= I_BR ? 1 : 0; if (second) r -= I_BR; const int nblk = D / 32, kb = r / nblk, nb = r % nblk;
        it.W = second ? OPQ(a.in[11]) : OPQ(a.in[10]); it.WT = (bf16*)(ws + WS_WB); it.ldk = D; it.N = D; it.k0 = 64 * kb; it.n0 = 32 * nb; it.drow0 = 32 * nb; it.kofs = second ? AW : 0; return it; } r -= 2 * I_BR;
    if (r < I_O) { const int nblk = D / 32, kb = r / nblk, nb = r % nblk;
        it.W = OPQ(a.in[12]); it.WT = (bf16*)(ws + WS_WO); it.ldk = D; it.N = D; it.k0 = 64 * kb; it.n0 = 32 * nb; it.drow0 = 32 * nb; return it; } r -= I_O;
    if (r < 2 * I_GU) { const int up = r >= I_GU ? 1 : 0; if (up) r -= I_GU; const int nblk = FF / 32, kb = r / nblk, nb = r % nblk, n0 = 32 * nb;
        it.W = up ? OPQ(a.in[15]) : OPQ(a.in[14]); it.WT = (bf16*)(ws + WS_WGU); it.ldk = D; it.N = FF; it.k0 = 64 * kb; it.n0 = n0; it.drow0 = 256 * (n0 >> 7) + 128 * up + (n0 & 127); if (MK_BF16_RESID) it.kscale = OPQ(a.in[13]); return it; } r -= 2 * I_GU;
    { const int nblk = D / 32, kb = r / nblk, nb = r % nblk;
      it.W = OPQ(a.in[16]); it.WT = (bf16*)(ws + WS_WD); it.ldk = FF; it.N = D; it.k0 = 64 * kb; it.n0 = 32 * nb; it.drow0 = 32 * nb; return it; }
}
__device__ __forceinline__ void p0_prologue(Frame& F, const Args& a, int item_lo, int item_hi, int gw, int NGW, bool rows) {
    LAS float* scr = (LAS float*)(F.lds + RING_OFF + F.wave * 16384);
    constexpr int I_IN = (D / 64) * (NIN / 32), I_BR = (AW / 64) * (D / 32), I_O = (D / 64) * (D / 32), I_GU = (D / 64) * (FF / 32), I_D = (FF / 64) * (D / 32);
    {
        f32x4 vc[8], vn[8];
        int it = gw >= 0 ? item_lo + gw : item_hi;
        P0Item cur = p0_decode(a, it < item_hi ? it : 0);
        if (it < item_hi) p0_item_load(cur, vc, F.lane);
        while (it < item_hi) {
            const int nx = it + NGW; const bool more = nx < item_hi;
            const P0Item nxt = p0_decode(a, more ? nx : 0);
            if (more) p0_item_load(nxt, vn, F.lane);
            p0_item_finish(cur, vc, scr, F.lane);
#pragma unroll
            for (int i = 0; i < 8; ++i) vc[i] = vn[i];
            cur = nxt; it = nx;
        }
    }
    if (!rows) return;
    const float* x = a.in[0]; const float* g = a.in[1]; bf16* XN = (bf16*)(a.ws + WS_XN);
    const GAS f32x4* gr = (const GAS f32x4*)g + F.lane;
    for (int m = gw; m < M; m += 4 * NGW) {
        f32x4 v[4][4];
#pragma unroll
        for (int q = 0; q < 4; ++q) { const GAS f32x4* xr = (const GAS f32x4*)(x + (size_t)(m + q * NGW) * D) + F.lane;
#pragma unroll
            for (int j = 0; j < 4; ++j) v[q][j] = __builtin_nontemporal_load(xr + 64 * j); }
        f32x4 gg[4];
#pragma unroll
        for (int j = 0; j < 4; ++j) gg[j] = gr[64 * j];
#pragma unroll
        for (int q = 0; q < 4; ++q) { float s = 0.f;
#pragma unroll
            for (int j = 0; j < 4; ++j) s += (v[q][j].x * v[q][j].x + v[q][j].y * v[q][j].y) + (v[q][j].z * v[q][j].z + v[q][j].w * v[q][j].w);
            const float rs = 1.0f / sqrtf(wave_sum(s) * (1.f / D) + 1e-6f);
            GAS unsigned long long* o8 = (GAS unsigned long long*)(XN + (size_t)(m + q * NGW) * D) + F.lane;
#pragma unroll
            for (int j = 0; j < 4; ++j) o8[64 * j] = (unsigned long long)pk2(v[q][j].x * rs * gg[j].x, v[q][j].y * rs * gg[j].y) | ((unsigned long long)pk2(v[q][j].z * rs * gg[j].z, v[q][j].w * rs * gg[j].w) << 32); }
    }
}

__global__ void __launch_bounds__(NWAVES * 64, 2) skel_fwd(Args args) {
    extern __shared__ __attribute__((aligned(16))) unsigned char lds[];
    Frame F;
    F.lds = (LAS unsigned char*)lds;
    F.MISC = (volatile LAS unsigned*)(F.lds + MISC_OFF);
    F.tid = threadIdx.x; F.lane = F.tid & 63; F.wave = __builtin_amdgcn_readfirstlane(F.tid >> 6);
    F.G = gridDim.x; { const int bx = blockIdx.x; F.vcu = (F.G % 8 == 0) ? (bx % 8) * (F.G / 8) + bx / 8 : bx; }
    unsigned char* ws = args.ws;
    F.ctl = (gu32*)(ws + WS_CTL);
    for (int u = F.tid; u < (LDS_BYTES - LDSCTL_OFF) / 4; u += NWAVES * 64) ((LAS unsigned*)(F.lds + LDSCTL_OFF))[u] = 0u;
    __syncthreads();
    const int lo = args.ph_lo, hi = args.ph_hi;
    if (F.tid == 0) __hip_atomic_store(F.ctl + CW_XCC + blockIdx.x, xb_xcc_id() + 1u, RLX_AGENT);
#if MK_CODE_PREFETCH
    unsigned long long pc0_; asm volatile("s_getpc_b64 %0" : "=s"(pc0_));
    const char* const code_slice = (const char*)pc0_ + (size_t)(blockIdx.x >> 3) * (MK_CODE_BYTES / 32) + 64 * F.lane;
#define CODE_TOUCH() do { if (F.wave == 0 && 64 * F.lane < MK_CODE_BYTES / 32) { unsigned cw_ = __builtin_nontemporal_load((const unsigned*)code_slice); asm volatile("" :: "v"(cw_)); } } while (0)
#else
#define CODE_TOUCH() do {} while (0)
#endif
#ifdef MK_STAMP_A
    unsigned long long ts_prev = __builtin_amdgcn_s_memrealtime(); const unsigned long long ts0 = ts_prev; unsigned enc_a = 0, enc_b = 0; int ts_n = 0;
#define STAMP() do { const unsigned long long now_ = __builtin_amdgcn_s_memrealtime(); const unsigned d_ = (unsigned)(now_ - ts_prev); if (ts_n == MK_STAMP_A) enc_a = d_; if (ts_n == MK_STAMP_B) enc_b = d_; ts_prev = now_; ++ts_n; } while (0)
#else
#define STAMP() do {} while (0)
#endif
    const bool multi = (hi - lo) > 1;
    XcdBarrier bar; bar.bar = (unsigned*)(F.ctl + CW_BAR); bar.x = 0; bar.st = nullptr;
    if (multi) bar = xcd_barrier_post((unsigned*)(F.ctl + CW_BAR), F.MISC + 8);
#define IN(k) (lo <= (k) && (k) < hi)
#define BOTH(k) (IN(k) && IN((k) + 1))
#define GRID_BAR() do { CODE_TOUCH(); xcd_barrier(bar); } while (0)
    unsigned grp_n = 0;
    bool grp_local = false;
#if MK_GROUP_BAR
#define GROUP_BAR() do { if (grp_local) { ++grp_n; group_barrier(F.ctl + CW_GRP + 64 * (blockIdx.x & 7), grp_n * (unsigned)(F.G >> 3), F.ctl + CW_TMO); } else GRID_BAR(); } while (0)
#else
#define GROUP_BAR() GRID_BAR()
#endif
    bf16* const WIN = (bf16*)(ws + WS_WIN); bf16* const WB = (bf16*)(ws + WS_WB); bf16* const WO = (bf16*)(ws + WS_WO);
    bf16* const WGU = (bf16*)(ws + WS_WGU); bf16* const WD = (bf16*)(ws + WS_WD);
    bf16* const XN = (bf16*)(ws + WS_XN); bf16* const Y = (bf16*)(ws + WS_Y);
    bf16* const QA = (bf16*)(ws + WS_QA); bf16* const KA = (bf16*)(ws + WS_KA); bf16* const VAT = (bf16*)(ws + WS_VAT); bf16* const QB = (bf16*)(ws + WS_QB);
    bf16* const KB = (bf16*)(ws + WS_KB); bf16* const VBT = (bf16*)(ws + WS_VBT); bf16* const GATE = (bf16*)(ws + WS_GATE);
    bf16* const OA = (bf16*)(ws + WS_OA); bf16* const OB = (bf16*)(ws + WS_OB); bf16* const X1B = (bf16*)(ws + WS_X1B); bf16* const U = (bf16*)(ws + WS_U);
    float* const SS = (float*)(ws + WS_SS);

#ifdef MK_TWOPASS
    for (int pass_ = 0; pass_ < 2; ++pass_) { if (pass_) GRID_BAR();
#endif
    constexpr int P0_I_IN = (D / 64) * (NIN / 32), P0_NITEMS = P0_I_IN + 2 * (AW / 64) * (D / 32) + (D / 64) * (D / 32) + 2 * (D / 64) * (FF / 32) + (FF / 64) * (D / 32);
    if (IN(0)) {
#ifdef MK_STAMP_A
        const unsigned p0_t0 = (unsigned)__builtin_amdgcn_s_memrealtime();
#endif
        p0_prologue(F, args, 0, P0_I_IN, F.vcu * NWAVES + F.wave, F.G * NWAVES, true);
#ifdef MK_STAMP_A
        { const unsigned p0_t1 = (unsigned)__builtin_amdgcn_s_memrealtime(); if (MK_STAMP_A == 30) enc_a = p0_t0 - (unsigned)ts0; if (MK_STAMP_A == 31) enc_a = p0_t1 - p0_t0; }
#endif
        if (BOTH(0)) { GRID_BAR();
            if (MK_GROUP_BAR && (F.G & 7) == 0 && F.G <= NWAVES * 64) { int ok = 1;
                if (F.tid < F.G) { const unsigned a_ = __hip_atomic_load(F.ctl + CW_XCC + F.tid, RLX_AGENT), r_ = __hip_atomic_load(F.ctl + CW_XCC + (F.tid & 7), RLX_AGENT); ok = (a_ != 0u && a_ == r_) ? 1 : 0; }
                grp_local = __syncthreads_and(ok) != 0; } }
        STAMP(); }

    if (IN(1)) {
        pg8::Gemm g{XN, WIN, M, NIN, D}; pg8::StaticOrder S; S.init(M, NIN, F.G, (int)blockIdx.x, MK_WGM_P1);
        LAS float* gl = (LAS float*)(F.lds + EPI_TAB_OFF);
        if (F.tid < 256) { const int w = F.tid >> 6, i = F.tid & 63; gl[F.tid] = (w == 0 ? args.in[3] : w == 1 ? args.in[4] : w == 2 ? args.in[6] : args.in[7])[i]; }
        __syncthreads();
        pg8::EpiInProj E{QA, KA, VAT, QB, KB, VBT, GATE, gl, gl + 64, gl + 128, gl + 192};
        pg8::gemm_phase<pg8::EpiInProj, pg8::StaticOrder, PG8_ALIGN, PG8_SP2>(F.lds + RING_OFF, g, S, E);
#if defined(MK_STAMP_A) && MK_STAMP_A >= 40
        if (F.tid == 0) { if (MK_STAMP_A == 41) enc_a = ((LAS unsigned*)(F.lds + LDSCTL_OFF + 128))[0]; if (MK_STAMP_A == 61) enc_a = ((LAS unsigned*)(F.lds + LDSCTL_OFF + 128))[1]; ((LAS unsigned*)(F.lds + LDSCTL_OFF + 128))[0] = 0u; }
#endif
        {
            const int heavy = (M / 256) * (NIN / 256) - 4 * F.G;
            const int light = F.G - heavy, me = (int)blockIdx.x - heavy;
            if (me >= 0 && me < 8) {
                att::Tensors AT0{nullptr, nullptr, nullptr, nullptr, nullptr, nullptr, nullptr, nullptr, args.in[5], args.in[3], args.in[4], args.in[6], args.in[7], args.in[8], args.in[9]};
                att::build_tables(F.lds + RING_OFF, (float*)(ws + WS_TABS), AT0, me, F.tid, F.wave, F.lane); }
            if (heavy > 0 && light > 0) p0_prologue(F, args, P0_I_IN, P0_NITEMS, me >= 0 ? me * NWAVES + F.wave : -1, light * NWAVES, false);
            else p0_prologue(F, args, P0_I_IN, P0_NITEMS, F.vcu * NWAVES + F.wave, F.G * NWAVES, false);
        }
        if (BOTH(1)) GRID_BAR();
        STAMP();
    }

    if (IN(2)) {
        att::Tensors AT{QA, KA, VAT, QB, KB, VBT, OA, OB, args.in[5], args.in[3], args.in[4], args.in[6], args.in[7], args.in[8], args.in[9]};
#ifdef MK_STAMP_A
        const unsigned p2_t0 = (unsigned)__builtin_amdgcn_s_memrealtime();
#endif
        att::attn_phase(F.lds + RING_OFF, AT, (const float*)(ws + WS_TABS), F.vcu, F.tid, F.wave, F.lane);
#ifdef MK_STAMP_A
        if (F.tid == 0) { const unsigned s0 = ((LAS unsigned*)(F.lds + LDSCTL_OFF + 64))[0], s1 = ((LAS unsigned*)(F.lds + LDSCTL_OFF + 64))[1], e_ = (unsigned)__builtin_amdgcn_s_memrealtime();
            if (MK_STAMP_A == 20) enc_a = s0 - p2_t0; if (MK_STAMP_A == 21) enc_a = s1 - s0; if (MK_STAMP_A == 22) enc_a = e_ - s1; }
#endif
        if (BOTH(2)) GROUP_BAR();
        STAMP();
    }

    if (IN(3)) {
        pg8::Gemm g{OA, WB, M, D, D}; pg8::StaticOrder S; S.init(M, D, F.G, (int)blockIdx.x);
        pg8::EpiBranch E{Y, GATE};
        pg8::gemm_phase<pg8::EpiBranch, pg8::StaticOrder, PG8_ALIGN, PG8_SP2>(F.lds + RING_OFF, g, S, E);
#if defined(MK_STAMP_A) && MK_STAMP_A >= 40
        if (F.tid == 0) { if (MK_STAMP_A == 43) enc_a = ((LAS unsigned*)(F.lds + LDSCTL_OFF + 128))[0]; if (MK_STAMP_A == 63) enc_a = ((LAS unsigned*)(F.lds + LDSCTL_OFF + 128))[1]; ((LAS unsigned*)(F.lds + LDSCTL_OFF + 128))[0] = 0u; }
#endif
        if (BOTH(3)) GROUP_BAR();
        STAMP();
    }

    if (IN(4)) {
        pg8::Gemm g{Y, WO, M, D, D}; pg8::StaticOrder S; S.init(M, D, F.G, (int)blockIdx.x);
        pg8::EpiOut E{args.in[0], MK_BF16_RESID ? nullptr : args.out, X1B, args.in[13], SS, MK_HOOK4(F.vcu)};
        pg8::gemm_phase<pg8::EpiOut, pg8::StaticOrder, false, PG8_SP2>(F.lds + RING_OFF, g, S, E);
#if defined(MK_STAMP_A) && MK_STAMP_A >= 40
        if (F.tid == 0) { if (MK_STAMP_A == 44) enc_a = ((LAS unsigned*)(F.lds + LDSCTL_OFF + 128))[0]; if (MK_STAMP_A == 64) enc_a = ((LAS unsigned*)(F.lds + LDSCTL_OFF + 128))[1]; ((LAS unsigned*)(F.lds + LDSCTL_OFF + 128))[0] = 0u; }
#endif
        if (BOTH(4)) GRID_BAR();
        STAMP();
#ifdef MK_EXTRA_BARS
        for (int xb_ = 0; xb_ < MK_EXTRA_BARS; ++xb_) GRID_BAR();
#endif
    }

    if (IN(5)) {
        pg8::Gemm g{X1B, WGU, M, 2 * FF, D}; pg8::StaticOrder S; S.init(M, 2 * FF, F.G, (int)blockIdx.x, MK_WGM_P5);
        LAS float* rl = (LAS float*)(F.lds + EPI_TAB_OFF);
        { const int rbase = 2048 * ((int)blockIdx.x & 7);
          for (int i = F.tid; i < 2048; i += NWAVES * 64) { const f32x4 q4 = *(const f32x4*)(SS + (size_t)(rbase + i) * 4); rl[i] = __builtin_amdgcn_rsqf(((q4[0] + q4[1]) + (q4[2] + q4[3])) * (1.0f / 1024.0f) + 1e-6f); } }
        __syncthreads();
        pg8::EpiGateUp E{rl, U, FF};
        pg8::gemm_phase<pg8::EpiGateUp, pg8::StaticOrder, PG8_ALIGN, PG8_SP2>(F.lds + RING_OFF, g, S, E);
#if defined(MK_STAMP_A) && MK_STAMP_A >= 40
        if (F.tid == 0) { if (MK_STAMP_A == 45) enc_a = ((LAS unsigned*)(F.lds + LDSCTL_OFF + 128))[0]; if (MK_STAMP_A == 65) enc_a = ((LAS unsigned*)(F.lds + LDSCTL_OFF + 128))[1]; ((LAS unsigned*)(F.lds + LDSCTL_OFF + 128))[0] = 0u; }
#endif
        if (BOTH(5)) GROUP_BAR();
        STAMP();
    }

    if (IN(6)) {
        pg8::Gemm g{U, WD, M, D, FF}; pg8::StaticOrder S; S.init(M, D, F.G, (int)blockIdx.x);
        pg8::EpiDown E{args.out, MK_HOOK6(F.vcu), MK_BF16_RESID ? X1B : nullptr};
        pg8::gemm_phase<pg8::EpiDown, pg8::StaticOrder, PG8_ALIGN, PG8_SP2>(F.lds + RING_OFF, g, S, E);
#if defined(MK_STAMP_A) && MK_STAMP_A >= 40
        if (F.tid == 0) { if (MK_STAMP_A == 46) enc_a = ((LAS unsigned*)(F.lds + LDSCTL_OFF + 128))[0]; if (MK_STAMP_A == 66) enc_a = ((LAS unsigned*)(F.lds + LDSCTL_OFF + 128))[1]; ((LAS unsigned*)(F.lds + LDSCTL_OFF + 128))[0] = 0u; }
#endif
        STAMP();
    }
#ifdef MK_TWOPASS
    }
#endif
#ifdef MK_STAMP_A
    if (MK_STAMP_A == 40) enc_a = ((LAS unsigned*)(F.lds + LDSCTL_OFF + 128))[0];
    if (MK_STAMP_A == 50 && blockIdx.x == 0 && F.tid == 0) {
        unsigned mism = 0; for (int b = 0; b < 256; ++b) mism += (__hip_atomic_load(F.ctl + CW_XCC + b, RLX_AGENT) != __hip_atomic_load(F.ctl + CW_XCC + (b & 7), RLX_AGENT)) ? 1u : 0u;
        unsigned distinct = 0; for (int b = 0; b < 8; ++b) { bool isnew = true; for (int c = 0; c < b; ++c) isnew = isnew && (__hip_atomic_load(F.ctl + CW_XCC + b, RLX_AGENT) != __hip_atomic_load(F.ctl + CW_XCC + c, RLX_AGENT)); distinct += isnew ? 1u : 0u; }
        enc_a = (mism * 100u + distinct) * 100u; }
    if (blockIdx.x == 0 && F.tid == 0) {
        const unsigned long long target = 100000ull + 3ull * (unsigned long long)enc_a + 0ull * enc_b;
        while (__builtin_amdgcn_s_memrealtime() - ts0 < target) __builtin_amdgcn_s_sleep(2);
    }
#endif
#undef IN
#undef BOTH
#undef GRID_BAR
}

extern "C" void kernel_launch(void* const* d_in, const int* in_sizes, int n_in, void* d_out, int out_size, void* d_ws, size_t ws_size, hipStream_t stream) {
    static int grid = 0;
    if (grid == 0) {
        if (n_in != 17 || in_sizes[0] != M * D || out_size != M * D || ws_size < WS_END) { fprintf(stderr, "kernel_launch: unexpected shapes (n_in %d, in0 %d, out %d, ws %zu); nothing launched\n", n_in, n_in > 0 ? in_sizes[0] : -1, out_size, ws_size); grid = -1; return; }
        int dev = 0, cus = 0, per_cu = 0;
        if (hipGetDevice(&dev) != hipSuccess || hipDeviceGetAttribute(&cus, hipDeviceAttributeMultiprocessorCount, dev) != hipSuccess) { grid = -1; return; }
        if (hipFuncSetAttribute((const void*)skel_fwd, hipFuncAttributeMaxDynamicSharedMemorySize, LDS_BYTES) != hipSuccess) { fprintf(stderr, "kernel_launch: hipFuncSetAttribute failed\n"); grid = -1; return; }
        if (hipOccupancyMaxActiveBlocksPerMultiprocessor(&per_cu, (const void*)skel_fwd, NWAVES * 64, LDS_BYTES) != hipSuccess || per_cu < 1) { fprintf(stderr, "kernel_launch: occupancy query says %d workgroups per CU\n", per_cu); per_cu = 1; }
        (void)hipGetLastError();
        grid = cus * per_cu < 256 ? cus * per_cu : 256;
        if (grid != 256) fprintf(stderr, "kernel_launch: grid %d (expected 256)\n", grid);
    }
    if (grid < 0) return;
    (void)hipMemsetAsync((char*)d_ws + WS_CTL, 0, CTL_ZERO_BYTES, stream);
    Args a{};
    for (int i = 0; i < 17; ++i) a.in[i] = (const float*)d_in[i];
    a.out = (float*)d_out; a.ws = (unsigned char*)d_ws;
#ifdef MK_DEBUG_MASK
    using namespace nv;
    unsigned char* ws = (unsigned char*)d_ws; float* out = (float*)d_out;
    Bufs b;
    b.QA = (nv::bf16*)(ws + WS_QA); b.KA = (nv::bf16*)(ws + WS_KA); b.VAT = (nv::bf16*)(ws + WS_VAT); b.QB = (nv::bf16*)(ws + WS_QB); b.KB = (nv::bf16*)(ws + WS_KB); b.VBT = (nv::bf16*)(ws + WS_VBT);
    b.GATE = (nv::bf16*)(ws + WS_GATE); b.OA = (nv::bf16*)(ws + WS_OA); b.OB = (nv::bf16*)(ws + WS_OB); b.Y = (nv::bf16*)(ws + WS_Y); b.X1B = (nv::bf16*)(ws + WS_X1B); b.U = (nv::bf16*)(ws + WS_U);
    b.RS1 = (float*)(ws + WS_RS1); b.SS = (float*)(ws + WS_SS);
    for (int k = 0; k < N_PHASES; ++k) {
        if ((MK_DEBUG_MASK >> k) & 1) { a.ph_lo = k; a.ph_hi = k + 1; hipLaunchKernelGGL(skel_fwd, dim3(grid), dim3(NWAVES * 64), LDS_BYTES, stream, a);
#ifdef DBG_TWICE
            if (k == DBG_TWICE) hipLaunchKernelGGL(skel_fwd, dim3(grid), dim3(NWAVES * 64), LDS_BYTES, stream, a);
#endif
            continue; }
        switch (k) {
        case 1: k_rowscale<<<M_ / 4, 256, 0, stream>>>(a.in[0], b.RS1);
                k_inproj<<<dim3(NIN_ / 64, M_ / 64), 256, 0, stream>>>(a.in[0], a.in[1], b.RS1, a.in[2], a.in[3], a.in[4], a.in[6], a.in[7], b);
                k_gatefix<<<M_ * 1024 / 256, 256, 0, stream>>>(b); break;
        case 2: k_natten<<<M_ * 8 / 256, 256, 0, stream>>>(a.in[5], b); k_swa<<<M_ * 8 / 256, 256, 0, stream>>>(a.in[8], a.in[9], b); break;
        case 3: k_branch<<<dim3(D_ / 64, M_ / 64), 256, 0, stream>>>(a.in[10], a.in[11], b); break;
        case 4: k_outproj<<<dim3(D_ / 64, M_ / 64), 256, 0, stream>>>(a.in[0], a.in[12], a.in[13], out, b); k_rowss<<<M_ / 4, 256, 0, stream>>>(out, b.SS); break;
        case 5: k_gateup<<<dim3(FF_ / 64, M_ / 64), 256, 0, stream>>>(out, a.in[13], a.in[14], a.in[15], b); break;
        case 6: k_down<<<dim3(D_ / 64, M_ / 64), 256, 0, stream>>>(a.in[16], out, b); break;
        default: break;
        }
    }
#else
    if (MK_REPEAT >= 0) {
        a.ph_lo = 0; a.ph_hi = MK_REPEAT + 1; hipLaunchKernelGGL(skel_fwd, dim3(grid), dim3(NWAVES * 64), LDS_BYTES, stream, a);
        (void)hipMemsetAsync((char*)d_ws + WS_CTL, 0, CTL_ZERO_BYTES, stream);
        a.ph_lo = MK_REPEAT; a.ph_hi = N_PHASES; hipLaunchKernelGGL(skel_fwd, dim3(grid), dim3(NWAVES * 64), LDS_BYTES, stream, a);
        return;
    }
    a.ph_lo = 0; a.ph_hi = N_PHASES;
    hipLaunchKernelGGL(skel_fwd, dim3(grid), dim3(NWAVES * 64), LDS_BYTES, stream, a);
#ifdef MK_TWICE
    (void)hipMemsetAsync((char*)d_ws + WS_CTL, 0, CTL_ZERO_BYTES, stream);
    hipLaunchKernelGGL(skel_fwd, dim3(grid), dim3(NWAVES * 64), LDS_BYTES, stream, a);
#endif
#endif
}
```

```cpp
#include <hip/hip_runtime.h>
#include <cstdio>
#include <cstdint>
#ifdef MK_DEBUG_MASK
#include <hip/hip_runtime.h>
#include <cstdint>
#include <cstddef>
namespace nv {
typedef unsigned short bf16;
__device__ __forceinline__ float bf2f(bf16 v) { return __uint_as_float(((unsigned)v) << 16); }
__device__ __forceinline__ bf16 f2bf(float f) { unsigned u = __float_as_uint(f); return (bf16)((u + 0x7fffu + ((u >> 16) & 1u)) >> 16); }

constexpr float QK_C2N = 0.125f * 1.4426950408889634f, LOG2EN = 1.4426950408889634f;
__host__ __device__ __forceinline__ size_t kblk(int nh, int b, int t, int h, int d) { return ((((size_t)(b * 1024 + (t >> 3)) * nh + h) * 8 + (d >> 3)) * 8 + (t & 7)) * 8 + (d & 7); }
__host__ __device__ __forceinline__ size_t vblk(int nh, int b, int t, int h, int d) { return (((size_t)(b * 1024 + (t >> 3)) * nh + h) * 64 + d) * 8 + (t & 7); }
constexpr int B_ = 2, T_ = 8192, D_ = 1024, M_ = B_ * T_, FF_ = 2816, NIN_ = 4352;

__global__ void k_rowscale(const float* __restrict__ x, float* __restrict__ rs) {
    const int gw = (blockIdx.x * blockDim.x + threadIdx.x) >> 6, lane = threadIdx.x & 63;
    if (gw >= M_) return;
    const float* r = x + (size_t)gw * D_;
    float s = 0.f;
    for (int i = lane; i < D_; i += 64) { const float v = r[i]; s += v * v; }
    for (int o = 1; o < 64; o <<= 1) s += __shfl_xor(s, o);
    if (lane == 0) rs[gw] = rsqrtf(s * (1.0f / D_) + 1e-6f);
}
__global__ void k_rowss(const float* __restrict__ x, float* __restrict__ ss) {
    const int gw = (blockIdx.x * blockDim.x + threadIdx.x) >> 6, lane = threadIdx.x & 63;
    if (gw >= M_) return;
    const float* r = x + (size_t)gw * D_;
    float s = 0.f;
    for (int i = lane; i < D_; i += 64) { const float v = r[i]; s += v * v; }
    for (int o = 1; o < 64; o <<= 1) s += __shfl_xor(s, o);
    if (lane < 4) ss[(size_t)gw * 4 + lane] = lane == 0 ? s : 0.f;
}

template <class LA>
__device__ __forceinline__ void tile_gemm(float (&acc)[4][4], LA la, const float* __restrict__ Bm, int ldb, int K, int m0, int n0, float* As, float* Bs) {
    const int tid = threadIdx.x, tx = tid & 15, ty = tid >> 4;
#pragma unroll
    for (int i = 0; i < 4; ++i)
#pragma unroll
        for (int j = 0; j < 4; ++j) acc[i][j] = 0.f;
    for (int k0 = 0; k0 < K; k0 += 16) {
#pragma unroll
        for (int i = 0; i < 4; ++i) { const int e = tid + i * 256, r = e >> 4, kk = e & 15; As[kk * 65 + r] = la(m0 + r, k0 + kk); }
#pragma unroll
        for (int i = 0; i < 4; ++i) { const int e = tid + i * 256, kk = e >> 6, c = e & 63; Bs[kk * 64 + c] = Bm[(size_t)(k0 + kk) * ldb + n0 + c]; }
        __syncthreads();
#pragma unroll
        for (int kk = 0; kk < 16; ++kk) {
            float a[4], b[4];
#pragma unroll
            for (int i = 0; i < 4; ++i) a[i] = As[kk * 65 + ty * 4 + i];
#pragma unroll
            for (int j = 0; j < 4; ++j) b[j] = Bs[kk * 64 + tx * 4 + j];
#pragma unroll
            for (int i = 0; i < 4; ++i)
#pragma unroll
                for (int j = 0; j < 4; ++j) acc[i][j] = fmaf(a[i], b[j], acc[i][j]);
        }
        __syncthreads();
    }
}

struct Bufs {
    bf16 *QA, *KA, *VAT, *QB, *KB, *VBT, *GATE, *OA, *OB, *Y, *X1B, *U;
    float *RS1, *SS;
};

__global__ void __launch_bounds__(256) k_inproj(const float* __restrict__ x, const float* __restrict__ g1, const float* __restrict__ rs1, const float* __restrict__ w_in,
                                                const float* __restrict__ qna, const float* __restrict__ kna, const float* __restrict__ qnb, const float* __restrict__ knb, Bufs b) {
    __shared__ float As[16 * 65], Bs[16 * 64], red[64 * 17];
    const int n0 = blockIdx.x * 64, m0 = blockIdx.y * 64, tid = threadIdx.x, tx = tid & 15, ty = tid >> 4;
    float acc[4][4];
    tile_gemm(acc, [&](int m, int k) { return x[(size_t)m * D_ + k] * g1[k]; }, w_in, NIN_, D_, m0, n0, As, Bs);
#pragma unroll
    for (int i = 0; i < 4; ++i) { const float r = rs1[m0 + ty * 4 + i];
#pragma unroll
        for (int j = 0; j < 4; ++j) acc[i][j] *= r; }
    const float* gn = nullptr;
    if (n0 < 512) gn = qna; else if (n0 < 1024) gn = kna; else if (n0 >= 1536 && n0 < 2048) gn = qnb; else if (n0 >= 2048 && n0 < 2176) gn = knb;
    if (gn) {
#pragma unroll
        for (int i = 0; i < 4; ++i) { float s = 0.f;
#pragma unroll
            for (int j = 0; j < 4; ++j) s += acc[i][j] * acc[i][j];
            red[(ty * 4 + i) * 17 + tx] = s; }
        __syncthreads();
#pragma unroll
        for (int i = 0; i < 4; ++i) { float s = 0.f;
            for (int t = 0; t < 16; ++t) s += red[(ty * 4 + i) * 17 + t];
            const float r = rsqrtf(s * (1.0f / 64.0f) + 1e-6f);
#pragma unroll
            for (int j = 0; j < 4; ++j) acc[i][j] = acc[i][j] * r * gn[tx * 4 + j]; }
    }
#pragma unroll
    for (int i = 0; i < 4; ++i) { const int m = m0 + ty * 4 + i;
#pragma unroll
        for (int j = 0; j < 4; ++j) { const int n = n0 + tx * 4 + j; const float v = acc[i][j];
            if (n < 512) b.QA[(size_t)m * 512 + n] = f2bf(v * QK_C2N);
            else if (n < 1024) { const int c = n - 512; b.KA[kblk(8, m / T_, m % T_, c >> 6, c & 63)] = f2bf(v); }
            else if (n < 1536) { const int c = n - 1024, h = c >> 6, d = c & 63, bb = m / T_, t = m % T_; b.VAT[vblk(8, bb, t, h, d)] = f2bf(v); }
            else if (n < 2048) b.QB[(size_t)m * 512 + (n - 1536)] = f2bf(v * QK_C2N);
            else if (n < 2176) { const int c = n - 2048; b.KB[kblk(2, m / T_, m % T_, c >> 6, c & 63)] = f2bf(v); }
            else if (n < 2304) { const int c = n - 2176, h = c >> 6, d = c & 63, bb = m / T_, t = m % T_; b.VBT[vblk(2, bb, t, h, d)] = f2bf(v); }
            else b.GATE[(size_t)m * 2048 + (n - 2304)] = f2bf(1.0f / (1.0f + expf(-v))); } }
}

__global__ void __launch_bounds__(256) k_natten(const float* __restrict__ rpb, Bufs b) {
    const int gid = blockIdx.x * 256 + threadIdx.x; if (gid >= M_ * 8) return;
    const int h = gid & 7, m = gid >> 3, bb = m / T_, t = m % T_, r = t >> 6, qc = t & 63;
    int rs = r - 4; rs = rs < 0 ? 0 : (rs > 120 ? 120 : rs);
    int ws = qc - 8; ws = ws < 0 ? 0 : (ws > 48 ? 48 : ws);
    float q[64], o[64];
#pragma unroll
    for (int d = 0; d < 64; ++d) { q[d] = bf2f(b.QA[(size_t)m * 512 + h * 64 + d]); o[d] = 0.f; }
    float mx = -3.0e38f, l = 0.f;
    for (int kr = 0; kr < 8; ++kr)
        for (int kc = 0; kc < 16; ++kc) {
            const int krow = rs + kr, kcol = ws + kc, tk = krow * 64 + kcol; const size_t mk = (size_t)bb * T_ + tk;
            float s = 0.f;
#pragma unroll
            for (int d = 0; d < 64; ++d) s = fmaf(q[d], bf2f(b.KA[kblk(8, bb, tk, h, d)]), s);
            const int dr = krow - r + 7, dc = kcol - qc + 15;
            s = s + rpb[(dr * 31 + dc) * 8 + h] * LOG2EN;
            const float mn = fmaxf(mx, s), f = exp2f(mx - mn), p = exp2f(s - mn);
            l = l * f + p; mx = mn;
#pragma unroll
            for (int d = 0; d < 64; ++d) o[d] = o[d] * f + p * bf2f(b.VAT[vblk(8, bb, tk, h, d)]);
        }
    const float il = 1.0f / l;
#pragma unroll
    for (int d = 0; d < 64; ++d) b.OA[(size_t)m * 1024 + h * 64 + d] = f2bf(o[d] * il);
}

__device__ __forceinline__ int t5_bucket(int rel) {
    const int n = rel < 0 ? -rel : rel;
    const int large = 8 + (n >= 12) + (n >= 16) + (n >= 23) + (n >= 32) + (n >= 46) + (n >= 64) + (n >= 91);
    return (rel > 0 ? 16 : 0) + (n < 8 ? n : large);
}
__global__ void __launch_bounds__(256) k_swa(const float* __restrict__ sink, const float* __restrict__ t5, Bufs b) {
    const int gid = blockIdx.x * 256 + threadIdx.x; if (gid >= M_ * 8) return;
    const int h = gid & 7, m = gid >> 3, bb = m / T_, t = m % T_, kvh = h >> 2;
    float q[64], o[64];
#pragma unroll
    for (int d = 0; d < 64; ++d) { q[d] = bf2f(b.QB[(size_t)m * 512 + h * 64 + d]); o[d] = 0.f; }
    float mx = sink[h] * LOG2EN, l = 1.0f;
    const int lo = t - 128 < 0 ? 0 : t - 128, hi = t + 128 > T_ - 1 ? T_ - 1 : t + 128;
    for (int tk = lo; tk <= hi; ++tk) {
        const size_t mk = (size_t)bb * T_ + tk;
        float s = 0.f;
#pragma unroll
        for (int d = 0; d < 64; ++d) s = fmaf(q[d], bf2f(b.KB[kblk(2, bb, tk, kvh, d)]), s);
        s = s + t5[t5_bucket(tk - t) * 8 + h] * LOG2EN;
        const float mn = fmaxf(mx, s), f = exp2f(mx - mn), p = exp2f(s - mn);
        l = l * f + p; mx = mn;
#pragma unroll
        for (int d = 0; d < 64; ++d) o[d] = o[d] * f + p * bf2f(b.VBT[vblk(2, bb, tk, kvh, d)]);
    }
    const float il = 1.0f / l;
#pragma unroll
    for (int d = 0; d < 64; ++d) b.OB[(size_t)m * 1024 + h * 64 + d] = f2bf(o[d] * il);
}

__global__ void __launch_bounds__(256) k_gatefix(Bufs b) {
    const size_t i = (size_t)blockIdx.x * 256 + threadIdx.x; const size_t m = i >> 10, n = i & 1023;
    const float sa = bf2f(b.GATE[m * 2048 + n]), sb = bf2f(b.GATE[m * 2048 + 1024 + n]);
    b.GATE[m * 2048 + n] = f2bf(sa / sb);
}
__global__ void __launch_bounds__(256) k_branch(const float* __restrict__ wba, const float* __restrict__ wbb, Bufs b) {
    __shared__ float As[16 * 65], Bs[16 * 64];
    const int n0 = blockIdx.x * 64, m0 = blockIdx.y * 64, tid = threadIdx.x, tx = tid & 15, ty = tid >> 4;
    float a1[4][4], a2[4][4];
    tile_gemm(a1, [&](int m, int k) { return bf2f(b.OA[(size_t)m * 1024 + k]); }, wba, D_, 512, m0, n0, As, Bs);
    tile_gemm(a2, [&](int m, int k) { return bf2f(b.OB[(size_t)m * 1024 + k]); }, wbb, D_, 512, m0, n0, As, Bs);
#pragma unroll
    for (int i = 0; i < 4; ++i) { const int m = m0 + ty * 4 + i;
#pragma unroll
        for (int j = 0; j < 4; ++j) { const int n = n0 + tx * 4 + j;
            const float ga = bf2f(b.GATE[(size_t)m * 2048 + n]), gb = bf2f(b.GATE[(size_t)m * 2048 + 1024 + n]);
            b.Y[(size_t)m * D_ + n] = f2bf(gb * (ga * a1[i][j] + a2[i][j])); } }
}
__global__ void __launch_bounds__(256) k_outproj(const float* __restrict__ x, const float* __restrict__ wout, const float* __restrict__ g2, float* __restrict__ out, Bufs b) {
    __shared__ float As[16 * 65], Bs[16 * 64];
    const int n0 = blockIdx.x * 64, m0 = blockIdx.y * 64, tid = threadIdx.x, tx = tid & 15, ty = tid >> 4;
    float a1[4][4];
    tile_gemm(a1, [&](int m, int k) { return bf2f(b.Y[(size_t)m * D_ + k]); }, wout, D_, D_, m0, n0, As, Bs);
#pragma unroll
    for (int i = 0; i < 4; ++i) { const int m = m0 + ty * 4 + i;
#pragma unroll
        for (int j = 0; j < 4; ++j) { const int n = n0 + tx * 4 + j; const float v = x[(size_t)m * D_ + n] + a1[i][j];
            out[(size_t)m * D_ + n] = v; b.X1B[(size_t)m * D_ + n] = f2bf(v * g2[n]); } }
}
__global__ void __launch_bounds__(256) k_gateup(const float* __restrict__ x1, const float* __restrict__ g2, const float* __restrict__ wg, const float* __restrict__ wu, Bufs b) {
    __shared__ float As[16 * 65], Bs[16 * 64];
    const int n0 = blockIdx.x * 64, m0 = blockIdx.y * 64, tid = threadIdx.x, tx = tid & 15, ty = tid >> 4;
    float a1[4][4], a2[4][4];
    auto la = [&](int m, int k) { return x1[(size_t)m * D_ + k] * g2[k]; };
    tile_gemm(a1, la, wg, FF_, D_, m0, n0, As, Bs);
    tile_gemm(a2, la, wu, FF_, D_, m0, n0, As, Bs);
#pragma unroll
    for (int i = 0; i < 4; ++i) { const int m = m0 + ty * 4 + i;
        const float* s4 = b.SS + (size_t)m * 4; const float r = rsqrtf(((s4[0] + s4[1]) + (s4[2] + s4[3])) * (1.0f / D_) + 1e-6f);
#pragma unroll
        for (int j = 0; j < 4; ++j) { const int n = n0 + tx * 4 + j; const float g = a1[i][j] * r, u = a2[i][j] * r;
            b.U[(size_t)m * FF_ + n] = f2bf(g / (1.0f + expf(-g)) * u); } }
}
__global__ void __launch_bounds__(256) k_down(const float* __restrict__ wd, float* __restrict__ out, Bufs b) {
    __shared__ float As[16 * 65], Bs[16 * 64];
    const int n0 = blockIdx.x * 64, m0 = blockIdx.y * 64, tid = threadIdx.x, tx = tid & 15, ty = tid >> 4;
    float a1[4][4];
    tile_gemm(a1, [&](int m, int k) { return bf2f(b.U[(size_t)m * FF_ + k]); }, wd, D_, FF_, m0, n0, As, Bs);
#pragma unroll
    for (int i = 0; i < 4; ++i) { const int m = m0 + ty * 4 + i;
#pragma unroll
        for (int j = 0; j < 4; ++j) { const int n = n0 + tx * 4 + j; out[(size_t)m * D_ + n] += a1[i][j]; } }
}
}
#endif
#if defined(MK_STAMP_A) && MK_STAMP_A >= 40
#define PG8_KSTAMP_BEGIN() const unsigned kst0_ = (unsigned)__builtin_amdgcn_s_memrealtime()
#define PG8_KSTAMP_END() do { if (tid == 0) ((PG8_LAS unsigned*)(lds + (155648 - 1024) + 128))[0] += (unsigned)__builtin_amdgcn_s_memrealtime() - kst0_; } while (0)
#if MK_STAMP_A >= 60
#ifndef MK_TRIP_T
#define MK_TRIP_T 2
#endif
#define PG8_KSTAMP_TRIP() do { if (tid == 0 && ui == 0 && t == MK_TRIP_T) ((PG8_LAS unsigned*)(lds + (155648 - 1024) + 128))[1] = (unsigned)__builtin_amdgcn_s_memrealtime() - kst0_; } while (0)
#else
#define PG8_KSTAMP_TRIP() do {} while (0)
#endif
#endif
namespace pg8 {
#define PG8_LAS __attribute__((address_space(3)))
typedef unsigned short bf16_t;
typedef short bf16x8 __attribute__((ext_vector_type(8)));
typedef float f32x4 __attribute__((ext_vector_type(4)));
typedef unsigned u32x4 __attribute__((ext_vector_type(4)));
constexpr int BM = 256, BK = 64, HALF = 128, HTB = HALF * BK * 2  , STAGE_BYTES = 8 * HTB, NXCD = 8, WGM = 8;

__host__ __device__ __forceinline__ int lds_byte(int r, int c) { const int st = (r >> 4) * 2 + (c >> 5), rr = r & 15, cc = c & 31, ob = rr * 64 + cc * 2; return st * 1024 + (ob ^ (((ob >> 9) & 1) << 5)); }
__host__ __device__ __forceinline__ void stage_rc(int b, int& R, int& C) { const int st = b / 1024, sb = b % 1024, swz = sb ^ (((sb >> 9) & 1) << 5); R = (st >> 1) * 16 + swz / 64; C = (st & 1) * 32 + (swz % 64) / 2; }
__host__ __device__ __forceinline__ int perm32(int rho) { const int n = rho >> 4, i = rho & 15; return 8 * (i >> 2) + 4 * n + (i & 3); }

struct Unit { int pm, pn; };
struct Gemm { const bf16_t* A; const bf16_t* Bt; int M, N, K; };

struct StaticOrder {
    int nM, nN, nwg, G, c, wgm;
    __host__ __device__ void init(int M, int N, int G_, int c_, int wgm_ = WGM) { nM = M / BM; nN = N / BM; nwg = nM * nN; G = G_; c = c_; wgm = wgm_; }
    __host__ __device__ bool next(int i, Unit& u) const {
        const long L = (long)i * G + c; if (L >= nwg) return false;
        int wgid = (int)L; { const int q = nwg / NXCD, r = nwg % NXCD, xcd = wgid % NXCD, off = wgid / NXCD; wgid = (xcd < r ? xcd * (q + 1) : r * (q + 1) + (xcd - r) * q) + off; }
        const int nig = wgm * nN, gid = wgid / nig, fm = gid * wgm, gsz = (nM - fm) < wgm ? (nM - fm) : wgm;
        u.pm = fm + ((wgid % nig) % gsz); u.pn = (wgid % nig) / gsz; return true;
    }
    __device__ __forceinline__ void a_ready(const Unit&) const {}
    __device__ __forceinline__ void done(const Unit&) const {}
};
__device__ __forceinline__ unsigned cvt_pk_bf16(float lo, float hi) { unsigned r; asm volatile("v_cvt_pk_bf16_f32 %0, %1, %2" : "=v"(r) : "v"(lo), "v"(hi)); return r; }
typedef float f32x2 __attribute__((ext_vector_type(2)));
#ifndef EPI_NT
#define EPI_NT 0
#endif
#if EPI_NT
#define EPI_ST(p, v) __builtin_nontemporal_store((v), (p))
#else
#define EPI_ST(p, v) (*(p) = (v))
#endif
#ifndef EPI_INIT_ACC
#define EPI_INIT_ACC 1
#endif
#ifndef EPI_NT_LD
#define EPI_NT_LD 1
#endif
#if EPI_NT_LD
#define EPI_LD(p) __builtin_nontemporal_load(p)
#else
#define EPI_LD(p) (*(p))
#endif
#ifndef EPI_WT
#define EPI_WT 1
#endif
#ifndef EPI_WT_QKV
#define EPI_WT_QKV 0
#endif
#ifndef EPI_WT_Y
#define EPI_WT_Y 0
#endif
typedef int epi_i32x4 __attribute__((ext_vector_type(4)));
__device__ __forceinline__ void store_wt16(void* p, u32x4 v) {
#if EPI_WT
    *(u32x4*)p = v;
#else
    *(u32x4*)p = v;
#endif
}
__device__ __forceinline__ void store_wt16(const __amdgpu_buffer_rsrc_t rsrc, unsigned byte_off, u32x4 v) {
    __builtin_amdgcn_raw_buffer_store_b128(__builtin_bit_cast(epi_i32x4, v), rsrc, (int)byte_off, 0, 16  );
}
typedef int epi_i32x2 __attribute__((ext_vector_type(2)));
__device__ __forceinline__ void store_wt8(const __amdgpu_buffer_rsrc_t rsrc, unsigned byte_off, unsigned lo, unsigned hi) {
    __builtin_amdgcn_raw_buffer_store_b64((epi_i32x2){(int)lo, (int)hi}, rsrc, (int)byte_off, 0, 16);
}
#define EPI_RSRC(p) __builtin_amdgcn_make_buffer_rsrc((void*)(p), 0, 0x7fffffff, 0x00020000)
constexpr float QK_C2 = 0.125f * 1.4426950408889634f;
constexpr float LOG2E = 1.4426950408889634f;
constexpr int EP_T = 8192;
typedef float epi_f32x2 __attribute__((ext_vector_type(2)));
typedef __bf16 epi_bf16x2 __attribute__((ext_vector_type(2)));
__device__ __forceinline__ unsigned cvt_pk_safe(float lo, float hi) { epi_f32x2 v = {lo, hi}; epi_bf16x2 b = __builtin_convertvector(v, epi_bf16x2); return __builtin_bit_cast(unsigned, b); }
__device__ __forceinline__ float fast_sigmoid(float v) { return __builtin_amdgcn_rcpf(1.0f + __builtin_amdgcn_exp2f(-LOG2E * v)); }
__device__ __forceinline__ float bf_lo(unsigned w) { return __uint_as_float(w << 16); }
__device__ __forceinline__ float bf_hi(unsigned w) { return __uint_as_float(w & 0xffff0000u); }

__device__ __forceinline__ size_t gate_blk(int pm, int q, int half, int ai, int m, int wr, int wc) { return (size_t)(((((((pm * 8 + q) * 2 + half) * 2 + ai) * 4 + m) * 2 + wr) * 4 + wc)) * 512; }
struct EpiInProj {
    static constexpr bool INIT_ACC = false;
    static constexpr bool PERM = true, AFTER_DRAIN = false; static constexpr int MID_T = -1;
    bf16_t *QA, *KA, *VAT, *QB, *KB, *VBT, *GATE; const PG8_LAS float *qna, *kna, *qnb, *knb;
    template <int MODE, int NH = 0> __device__ __forceinline__ void rowmajor(const f32x4 (&acc)[2][2][4][2], bf16_t* dst, int ld, int row0, int fq, const PG8_LAS float* gain, float scale, int hb = 0) const {
        const __amdgpu_buffer_rsrc_t drs = EPI_RSRC(dst);
        f32x4 g[2][2];
        if (MODE == 1) {
#pragma unroll
            for (int bj = 0; bj < 2; ++bj)
#pragma unroll
                for (int n = 0; n < 2; ++n) g[bj][n] = *(const PG8_LAS f32x4*)(gain + 32 * bj + 8 * fq + 4 * n) * scale;
        }
#pragma unroll
        for (int ai = 0; ai < 2; ++ai)
#pragma unroll
            for (int m = 0; m < 4; ++m) {
                const int t_ = row0 + ai * HALF + m * 16;
                bf16_t* rowp = NH ? dst + ((size_t)((t_ >> 3) * NH + hb) * 64 + fq * 8 + (t_ & 7)) * 8 : dst + (size_t)t_ * ld + 8 * fq;
                f32x4 v[2][2];
#pragma unroll
                for (int bj = 0; bj < 2; ++bj)
#pragma unroll
                    for (int n = 0; n < 2; ++n) v[bj][n] = acc[ai][bj][m][n];
                if (MODE == 1) {
                    float ss = 0.f;
#pragma unroll
                    for (int bj = 0; bj < 2; ++bj)
#pragma unroll
                        for (int n = 0; n < 2; ++n) { const f32x4 x = v[bj][n]; ss += (x[0] * x[0] + x[1] * x[1]) + (x[2] * x[2] + x[3] * x[3]); }
                    ss += __shfl_xor(ss, 16); ss += __shfl_xor(ss, 32);
                    const float r = __builtin_amdgcn_rsqf(ss * (1.0f / 64.0f) + 1e-6f);
#pragma unroll
                    for (int bj = 0; bj < 2; ++bj)
#pragma unroll
                        for (int n = 0; n < 2; ++n) v[bj][n] = v[bj][n] * r * g[bj][n];
                } else if (MODE == 2) {
#pragma unroll
                    for (int bj = 0; bj < 2; ++bj)
#pragma unroll
                        for (int n = 0; n < 2; ++n)
#pragma unroll
                            for (int e = 0; e < 4; ++e) v[bj][n][e] = fast_sigmoid(v[bj][n][e]);
                }
#pragma unroll
                for (int bj = 0; bj < 2; ++bj) { u32x4 w; w.x = cvt_pk_safe(v[bj][0][0], v[bj][0][1]); w.y = cvt_pk_safe(v[bj][0][2], v[bj][0][3]); w.z = cvt_pk_safe(v[bj][1][0], v[bj][1][1]); w.w = cvt_pk_safe(v[bj][1][2], v[bj][1][3]);
                    if (EPI_WT_QKV) store_wt16(drs, (unsigned)((size_t)((rowp + (NH ? 256 : 32) * bj) - dst) * 2), w); else EPI_ST((u32x4*)(rowp + (NH ? 256 : 32) * bj), w); }
            }
    }
    template <int NH> __device__ __forceinline__ void vblocked(const f32x4 (&acc)[2][2][4][2], bf16_t* dst, int t0, int fq, int hb) const {
#pragma unroll
        for (int ai = 0; ai < 2; ++ai)
#pragma unroll
            for (int m = 0; m < 4; ++m) { const int t_ = t0 + ai * HALF + m * 16; bf16_t* tp = dst + ((size_t)((t_ >> 3) * NH + hb) * 64 + 8 * fq) * 8 + (t_ & 7);
#pragma unroll
                for (int bj = 0; bj < 2; ++bj)
#pragma unroll
                    for (int n = 0; n < 2; ++n)
#pragma unroll
                        for (int e = 0; e < 4; e += 2) { const unsigned w = cvt_pk_safe(acc[ai][bj][m][n][e], acc[ai][bj][m][n][e + 1]); const int d = 32 * bj + 4 * n + e;
                            tp[d * 8] = (bf16_t)(w & 0xffffu); tp[(d + 1) * 8] = (bf16_t)(w >> 16); } }
    }
    __device__ __forceinline__ void operator()(const f32x4 (&acc)[2][2][4][2], const Unit& u, int wr, int wc, int fr, int fq) const {
        asm volatile("" : "+v"(fr), "+v"(fq));
        const int pn = u.pn, row0 = u.pm * BM + wr * 64 + fr;
        const int b = (u.pm * BM) / EP_T, t0 = (u.pm * BM) % EP_T + wr * 64 + fr;
        if (pn < 2) rowmajor<1>(acc, QA + pn * 256 + 64 * wc, 512, row0, fq, qna, QK_C2);
        else if (pn < 4) rowmajor<1, 8>(acc, KA, 0, t0, fq, kna, 1.0f, b * 1024 * 8 + (pn - 2) * 4 + wc);
        else if (pn < 6) vblocked<8>(acc, VAT, t0, fq, b * 1024 * 8 + (pn - 4) * 4 + wc);
        else if (pn < 8) rowmajor<1>(acc, QB + (pn - 6) * 256 + 64 * wc, 512, row0, fq, qnb, QK_C2);
        else if (pn == 8) { if (wc < 2) rowmajor<1, 2>(acc, KB, 0, t0, fq, knb, 1.0f, b * 1024 * 2 + wc);
                            else vblocked<2>(acc, VBT, t0, fq, b * 1024 * 2 + (wc - 2)); }
        else gates(acc, GATE, u.pm, pn - 9, wr, wc, fr + 16 * fq);
    }
    __device__ __forceinline__ void gates(const f32x4 (&acc)[2][2][4][2], bf16_t* dst  , int pm, int q, int wr, int wc, int lane) const {
        const __amdgpu_buffer_rsrc_t grs = EPI_RSRC(dst);
#pragma unroll
        for (int ai = 0; ai < 2; ++ai)
#pragma unroll
            for (int m = 0; m < 4; ++m) { bf16_t* p1 = dst + gate_blk(pm, q, 0, ai, m, wr, wc) + lane * 8; bf16_t* p2 = dst + gate_blk(pm, q, 1, ai, m, wr, wc) + lane * 8; float g1[8], g2[8];
#pragma unroll
                for (int n = 0; n < 2; ++n)
#pragma unroll
                    for (int e = 0; e < 4; ++e) { const float ea = __builtin_amdgcn_exp2f(-LOG2E * acc[ai][0][m][n][e]), eb = fminf(__builtin_amdgcn_exp2f(-LOG2E * acc[ai][1][m][n][e]), 1.0e30f);
                        g2[4 * n + e] = __builtin_amdgcn_rcpf(1.0f + eb); g1[4 * n + e] = (1.0f + eb) * __builtin_amdgcn_rcpf(1.0f + ea); }
                u32x4 w1, w2;
                w1.x = cvt_pk_safe(g1[0], g1[1]); w1.y = cvt_pk_safe(g1[2], g1[3]); w1.z = cvt_pk_safe(g1[4], g1[5]); w1.w = cvt_pk_safe(g1[6], g1[7]);
                w2.x = cvt_pk_safe(g2[0], g2[1]); w2.y = cvt_pk_safe(g2[2], g2[3]); w2.z = cvt_pk_safe(g2[4], g2[5]); w2.w = cvt_pk_safe(g2[6], g2[7]);
                if (EPI_WT_QKV) { store_wt16(grs, (unsigned)((size_t)(p1 - dst) * 2), w1); store_wt16(grs, (unsigned)((size_t)(p2 - dst) * 2), w2); } else { EPI_ST((u32x4*)p1, w1); EPI_ST((u32x4*)p2, w2); } }
    }
};

struct EpiBranch {
    static constexpr bool INIT_ACC = false;
    static constexpr bool PERM = true, AFTER_DRAIN = false; static constexpr int MID_T = 8;
    bf16_t* Y; const bf16_t* GATE;
    __device__ __forceinline__ int mid_t() const { return MID_T; }
    template <int OFF> __device__ __forceinline__ void scale(f32x4 (&acc)[2][2][4][2], const Unit& u, int wr, int wc, int fr, int fq, bool store) const {
        asm volatile("" : "+v"(fr), "+v"(fq));
        const int row0 = u.pm * BM + wr * 64 + fr, col0 = u.pn * BM + wc * 32 + 8 * fq;
        const __amdgpu_buffer_rsrc_t yrs = EPI_RSRC(Y);
#pragma unroll
        for (int ai = 0; ai < 2; ++ai)
#pragma unroll
            for (int m = 0; m < 4; ++m) { const size_t row = (size_t)(row0 + ai * HALF + m * 16);
#pragma unroll
                for (int bj = 0; bj < 2; ++bj) {
                    const u32x4 gw = EPI_LD((const u32x4*)(GATE + gate_blk(u.pm, 2 * u.pn + bj, OFF ? 1 : 0, ai, m, wr, wc) + (fr + 16 * fq) * 8));
                    f32x4 v0 = acc[ai][bj][m][0], v1 = acc[ai][bj][m][1];
                    v0[0] *= bf_lo(gw.x); v0[1] *= bf_hi(gw.x); v0[2] *= bf_lo(gw.y); v0[3] *= bf_hi(gw.y); v1[0] *= bf_lo(gw.z); v1[1] *= bf_hi(gw.z); v1[2] *= bf_lo(gw.w); v1[3] *= bf_hi(gw.w);
                    if (store) { u32x4 w; w.x = cvt_pk_safe(v0[0], v0[1]); w.y = cvt_pk_safe(v0[2], v0[3]); w.z = cvt_pk_safe(v1[0], v1[1]); w.w = cvt_pk_safe(v1[2], v1[3]);
                        if (EPI_WT_Y) store_wt16(yrs, (unsigned)((row * 1024 + col0 + bj * HALF) * 2), w); else *(u32x4*)(Y + row * 1024 + col0 + bj * HALF) = w; }
                    else { acc[ai][bj][m][0] = v0; acc[ai][bj][m][1] = v1; } } }
    }
    __device__ __forceinline__ void mid(f32x4 (&acc)[2][2][4][2], const Unit& u, int wr, int wc, int fr, int fq) const { scale<0>(acc, u, wr, wc, fr, fq, false); }
    __device__ __forceinline__ void operator()(const f32x4 (&acc)[2][2][4][2], const Unit& u, int wr, int wc, int fr, int fq) const {
        scale<1024>(const_cast<f32x4 (&)[2][2][4][2]>(acc), u, wr, wc, fr, fq, true); }
};

constexpr bool RES_PERM = true; constexpr int RC_FQ = RES_PERM ? 8 : 4, RC_N = RES_PERM ? 4 : 16;
__device__ __forceinline__ void add_residual_tile(f32x4 (&acc)[2][2][4][2], const float* src, const Unit& u, int wr, int wc, int fr, int fq) {
    asm volatile("" : "+v"(fr), "+v"(fq));
    const int row0 = u.pm * BM + wr * 64 + fr, col0 = u.pn * BM + wc * 32 + RC_FQ * fq;
#pragma unroll
    for (int ai = 0; ai < 2; ++ai) {
        f32x4 t[4][2][2];
#pragma unroll
        for (int m = 0; m < 4; ++m) { const float* rowp = src + (size_t)(row0 + ai * HALF + m * 16) * 1024 + col0;
#pragma unroll
            for (int bj = 0; bj < 2; ++bj)
#pragma unroll
                for (int n = 0; n < 2; ++n) t[m][bj][n] = EPI_LD((const f32x4*)(rowp + bj * HALF + n * RC_N)); }
        asm volatile("" : "+v"(t[0][0][0]), "+v"(t[0][0][1]), "+v"(t[0][1][0]), "+v"(t[0][1][1]), "+v"(t[1][0][0]), "+v"(t[1][0][1]), "+v"(t[1][1][0]), "+v"(t[1][1][1]),
                          "+v"(t[2][0][0]), "+v"(t[2][0][1]), "+v"(t[2][1][0]), "+v"(t[2][1][1]), "+v"(t[3][0][0]), "+v"(t[3][0][1]), "+v"(t[3][1][0]), "+v"(t[3][1][1]));
#pragma unroll
        for (int m = 0; m < 4; ++m)
#pragma unroll
            for (int bj = 0; bj < 2; ++bj)
#pragma unroll
                for (int n = 0; n < 2; ++n) acc[ai][bj][m][n] = acc[ai][bj][m][n] + t[m][bj][n];
        asm volatile("" ::: "memory"); }
}

__device__ __forceinline__ void add_residual_tile_bf16(f32x4 (&acc)[2][2][4][2], const bf16_t* src, const Unit& u, int wr, int wc, int fr, int fq) {
    typedef unsigned u32x2v __attribute__((ext_vector_type(2)));
    asm volatile("" : "+v"(fr), "+v"(fq));
    const int row0 = u.pm * BM + wr * 64 + fr, col0 = u.pn * BM + wc * 32 + RC_FQ * fq;
    u32x2v t[2][4][2][2];
#pragma unroll
    for (int ai = 0; ai < 2; ++ai)
#pragma unroll
        for (int m = 0; m < 4; ++m) { const bf16_t* rowp = src + (size_t)(row0 + ai * HALF + m * 16) * 1024 + col0;
#pragma unroll
            for (int bj = 0; bj < 2; ++bj)
#pragma unroll
                for (int n = 0; n < 2; ++n) t[ai][m][bj][n] = EPI_LD((const u32x2v*)(rowp + bj * HALF + n * RC_N)); }
#pragma unroll
    for (int ai = 0; ai < 2; ++ai)
        asm volatile("" : "+v"(t[ai][0][0][0]), "+v"(t[ai][0][0][1]), "+v"(t[ai][0][1][0]), "+v"(t[ai][0][1][1]), "+v"(t[ai][1][0][0]), "+v"(t[ai][1][0][1]), "+v"(t[ai][1][1][0]), "+v"(t[ai][1][1][1]),
                          "+v"(t[ai][2][0][0]), "+v"(t[ai][2][0][1]), "+v"(t[ai][2][1][0]), "+v"(t[ai][2][1][1]), "+v"(t[ai][3][0][0]), "+v"(t[ai][3][0][1]), "+v"(t[ai][3][1][0]), "+v"(t[ai][3][1][1]));
#pragma unroll
    for (int ai = 0; ai < 2; ++ai)
#pragma unroll
        for (int m = 0; m < 4; ++m)
#pragma unroll
            for (int bj = 0; bj < 2; ++bj)
#pragma unroll
                for (int n = 0; n < 2; ++n) { const u32x2v w = t[ai][m][bj][n]; acc[ai][bj][m][n] = acc[ai][bj][m][n] + (f32x4){bf_lo(w.x), bf_hi(w.x), bf_lo(w.y), bf_hi(w.y)}; }
}

struct EpiOut {
    static constexpr bool PERM = RES_PERM, AFTER_DRAIN = true; static constexpr int MID_T = EPI_INIT_ACC ? -1 : 0; static constexpr bool INIT_ACC = EPI_INIT_ACC;
    __device__ __forceinline__ void init_acc(f32x4 (&acc)[2][2][4][2], const Unit& u, int wr, int wc, int fr, int fq) const {
        const int row0 = u.pm * BM + wr * 64 + fr, col0 = u.pn * BM + wc * 32 + RC_FQ * fq;
#pragma unroll
        for (int ai = 0; ai < 2; ++ai)
#pragma unroll
            for (int m = 0; m < 4; ++m) { const float* rowp = x + (size_t)(row0 + ai * HALF + m * 16) * 1024 + col0;
#pragma unroll
                for (int bj = 0; bj < 2; ++bj)
#pragma unroll
                    for (int n = 0; n < 2; ++n) acc[ai][bj][m][n] = EPI_LD((const f32x4*)(rowp + bj * HALF + n * RC_N)); }
    }
    const float* x; float* out; bf16_t* X1B; const float* g2; float* SS; int midt;
    __device__ __forceinline__ int mid_t() const { return midt; }
    __device__ __forceinline__ void mid(f32x4 (&acc)[2][2][4][2], const Unit& u, int wr, int wc, int fr, int fq) const { add_residual_tile(acc, x, u, wr, wc, fr, fq); }
    __device__ __forceinline__ void fused(f32x4 (&acc)[2][2][4][2], const Unit& u, int wr, int wc, int fr, int fq, PG8_LAS unsigned char* lds, int wid, int lane) const {
        typedef unsigned u32x2v __attribute__((ext_vector_type(2)));
        PG8_LAS float* P = (PG8_LAS float*)lds;
        const __amdgpu_buffer_rsrc_t xrs = EPI_RSRC(X1B);
        const int col0 = u.pn * BM + wc * 32 + RC_FQ * fq;
        f32x4 gv[2][2];
#pragma unroll
        for (int bj = 0; bj < 2; ++bj)
#pragma unroll
            for (int n = 0; n < 2; ++n) gv[bj][n] = out ? *(const f32x4*)(g2 + col0 + bj * HALF + n * RC_N) : (f32x4){1.f, 1.f, 1.f, 1.f};
#pragma unroll
        for (int ai = 0; ai < 2; ++ai)
#pragma unroll
            for (int m = 0; m < 4; ++m) { const int r = ai * HALF + wr * 64 + m * 16 + fr; const size_t off = (size_t)(u.pm * BM + r) * 1024 + col0; float ss = 0.f;
#pragma unroll
                for (int bj = 0; bj < 2; ++bj)
#pragma unroll
                    for (int n = 0; n < 2; ++n) { const f32x4 v = acc[ai][bj][m][n];
                        if (out) *(f32x4*)(out + off + bj * HALF + n * RC_N) = v; ss += (v[0] * v[0] + v[1] * v[1]) + (v[2] * v[2] + v[3] * v[3]);
                        const f32x4 h = v * gv[bj][n]; u32x2v w; w.x = cvt_pk_safe(h[0], h[1]); w.y = cvt_pk_safe(h[2], h[3]); if (EPI_WT_Y) store_wt8(xrs, (unsigned)((off + bj * HALF + n * RC_N) * 2), w.x, w.y); else *(u32x2v*)(X1B + off + bj * HALF + n * RC_N) = w; }
                ss += __shfl_xor(ss, 16); ss += __shfl_xor(ss, 32);
                if (fq == 0) P[r * 4 + wc] = ss;
                if (m & 1) asm volatile("" ::: "memory"); }
        asm volatile("s_waitcnt lgkmcnt(0)" ::: "memory"); __builtin_amdgcn_s_barrier(); asm volatile("" ::: "memory");
        const int t = wid * 64 + lane;
        if (t < 256) { const float s = (P[t * 4 + 0] + P[t * 4 + 1]) + (P[t * 4 + 2] + P[t * 4 + 3]); SS[(size_t)(u.pm * BM + t) * 4 + u.pn] = s; }
    }
};

struct EpiGateUp {
    static constexpr bool INIT_ACC = false;
    static constexpr bool PERM = true, AFTER_DRAIN = false; static constexpr int MID_T = -1;
    const PG8_LAS float* R; bf16_t* U; int ldu;
    __device__ __forceinline__ void operator()(const f32x4 (&acc)[2][2][4][2], const Unit& u, int wr, int wc, int fr, int fq) const {
        asm volatile("" : "+v"(fr), "+v"(fq));
        const int row0 = u.pm * BM + wr * 64 + fr, col0 = u.pn * HALF + wc * 32 + 8 * fq;
        const __amdgpu_buffer_rsrc_t urs = __builtin_amdgcn_make_buffer_rsrc(U, 0, 0x7fffffff, 0x00020000);
#pragma unroll
        for (int ai = 0; ai < 2; ++ai)
#pragma unroll
            for (int m = 0; m < 4; ++m) { const size_t row = (size_t)(row0 + ai * HALF + m * 16);
                const float r = R[(row0 + ai * HALF + m * 16) & 2047];
                const float c1 = -LOG2E * r, c2 = r * r; u32x4 w;
#pragma unroll
                for (int n = 0; n < 2; ++n) { const f32x4 g4 = acc[ai][0][m][n], u4 = acc[ai][1][m][n];
#pragma unroll
                    for (int p = 0; p < 2; ++p) { const epi_f32x2 g = {g4[2 * p], g4[2 * p + 1]}, up = {u4[2 * p], u4[2 * p + 1]};
                        const epi_f32x2 a = g * c1; epi_f32x2 e = {__builtin_amdgcn_exp2f(a.x), __builtin_amdgcn_exp2f(a.y)}; e = e + 1.0f;
                        epi_f32x2 sg = {__builtin_amdgcn_rcpf(e.x), __builtin_amdgcn_rcpf(e.y)}; const epi_f32x2 hh = (g * up) * (sg * c2);
                        w[2 * n + p] = cvt_pk_safe(hh.x, hh.y); } }
                if (EPI_WT) store_wt16(urs, (unsigned)((row * ldu + col0) * 2), w); else EPI_ST((u32x4*)(U + row * ldu + col0), w); }
    }
};

struct EpiDown {
    static constexpr bool PERM = RES_PERM, AFTER_DRAIN = false; static constexpr int MID_T = EPI_INIT_ACC ? -1 : 0; static constexpr bool INIT_ACC = EPI_INIT_ACC;
    __device__ __forceinline__ void init_acc(f32x4 (&acc)[2][2][4][2], const Unit& u, int wr, int wc, int fr, int fq) const {
        if (x1b) add_residual_tile_bf16(acc, x1b, u, wr, wc, fr, fq); else add_residual_tile(acc, out, u, wr, wc, fr, fq);
    }
    float* out; int midt; const bf16_t* x1b;
    __device__ __forceinline__ int mid_t() const { return midt; }
    __device__ __forceinline__ void mid(f32x4 (&acc)[2][2][4][2], const Unit& u, int wr, int wc, int fr, int fq) const { if (x1b) add_residual_tile_bf16(acc, x1b, u, wr, wc, fr, fq); else add_residual_tile(acc, out, u, wr, wc, fr, fq); }
    __device__ __forceinline__ void operator()(const f32x4 (&acc)[2][2][4][2], const Unit& u, int wr, int wc, int fr, int fq) const {
        const int row0 = u.pm * BM + wr * 64 + fr, col0 = u.pn * BM + wc * 32 + RC_FQ * fq;
#pragma unroll
        for (int ai = 0; ai < 2; ++ai)
#pragma unroll
            for (int m = 0; m < 4; ++m) { float* rowp = out + (size_t)(row0 + ai * HALF + m * 16) * 1024 + col0;
#pragma unroll
                for (int bj = 0; bj < 2; ++bj)
#pragma unroll
                    for (int n = 0; n < 2; ++n) EPI_ST((f32x4*)(rowp + bj * HALF + n * RC_N), acc[ai][bj][m][n]); }
    }
};
#ifndef PG8_KSTAMP_BEGIN
#define PG8_KSTAMP_BEGIN() do {} while (0)
#define PG8_KSTAMP_END() do {} while (0)
#define PG8_KSTAMP_TRIP() do {} while (0)
#endif
#ifndef PG8_AUX_A
#define PG8_AUX_A 0
#endif
#ifndef PG8_AUX_B
#define PG8_AUX_B 0
#endif
template <class Epi, class Sched, bool ALIGN_EPI = false, bool SP2 = false>
__device__ __forceinline__ void gemm_phase(PG8_LAS unsigned char* lds, const Gemm g, const Sched& S, const Epi& E) {
    const int tid = threadIdx.x, wid = __builtin_amdgcn_readfirstlane(tid >> 6), lane = tid & 63, wr = wid >> 2, wc = wid & 3, fr = lane & 15, fq = lane >> 4;
    const int K = g.K, nt = K / BK;
    unsigned voffA[2], voffB[2];
#pragma unroll
    for (int i = 0; i < 2; ++i) { int R, C; stage_rc(tid * 16 + i * 8192, R, C); const int Rb = Epi::PERM ? ((R & ~31) + perm32(R & 31)) : R;
        voffA[i] = (unsigned)(R * K + C) * 2u; voffB[i] = (unsigned)(Rb * K + C) * 2u; }
    const size_t kstep = (size_t)(BK * 2);
    const size_t hstep = (size_t)HALF * K * 2;
    const size_t tstep = 2 * hstep;
    const unsigned ldsw = (unsigned)wid * 1024u;
    const int aoff = lds_byte(wr * 64 + fr, fq * 8), boff = lds_byte(wc * 32 + fr, fq * 8);
#define PG8_SA(b, h) (((b) * 2 + (h)) * HTB)
#define PG8_SB(b, h) ((4 + (b) * 2 + (h)) * HTB)
#define PG8_STAGE(bufoff, gbase, voff) do { _Pragma("unroll") for (int _i = 0; _i < 2; ++_i) { \
        if ((bufoff) >= 4 * HTB) __builtin_amdgcn_global_load_lds((const unsigned*)((const char*)(gbase) + (voff)[_i]), (PG8_LAS unsigned*)(lds + (bufoff) + ldsw + _i * 8192), 16, 0, PG8_AUX_B); \
        else __builtin_amdgcn_global_load_lds((const unsigned*)((const char*)(gbase) + (voff)[_i]), (PG8_LAS unsigned*)(lds + (bufoff) + ldsw + _i * 8192), 16, 0, PG8_AUX_A); } } while (0)
#define PG8_LDA(dst, b, h) do { _Pragma("unroll") for (int m = 0; m < 4; ++m) _Pragma("unroll") for (int k = 0; k < 2; ++k) dst[m][k] = *(const PG8_LAS bf16x8*)(lds + PG8_SA(b, h) + aoff + m * 2048 + k * 1024); } while (0)
#define PG8_LDB(dst, b, h) do { _Pragma("unroll") for (int n = 0; n < 2; ++n) _Pragma("unroll") for (int k = 0; k < 2; ++k) dst[n][k] = *(const PG8_LAS bf16x8*)(lds + PG8_SB(b, h) + boff + n * 2048 + k * 1024); } while (0)
#define PG8_MMA(ai, bj, At, Bt) do { __builtin_amdgcn_s_setprio(1); _Pragma("unroll") for (int m = 0; m < 4; ++m) _Pragma("unroll") for (int n = 0; n < 2; ++n) _Pragma("unroll") for (int k = 0; k < 2; ++k) \
        acc[ai][bj][m][n] = __builtin_amdgcn_mfma_f32_16x16x32_bf16(Bt[n][k], At[m][k], acc[ai][bj][m][n], 0, 0, 0); __builtin_amdgcn_s_setprio(0); } while (0)
#define PG8_WAIT_V(n) asm volatile("s_waitcnt vmcnt(" #n ")" ::: "memory")
#define PG8_WAIT_L(n) asm volatile("s_waitcnt lgkmcnt(" #n ")" ::: "memory")
#define PG8_BAR __builtin_amdgcn_s_barrier()
#define PG8_SCHED __builtin_amdgcn_sched_barrier(0)
    Unit cur, nxt; int ui = 0;
    if (!S.next(0, cur)) return;
    f32x4 acc[2][2][4][2];
#pragma unroll
    for (int a = 0; a < 2; ++a)
#pragma unroll
        for (int b = 0; b < 2; ++b)
#pragma unroll
            for (int m = 0; m < 4; ++m)
#pragma unroll
                for (int n = 0; n < 2; ++n) acc[a][b][m][n] = (f32x4){0.f, 0.f, 0.f, 0.f};
    if constexpr (Epi::INIT_ACC) E.init_acc(acc, cur, wr, wc, fr, fq);
    bf16x8 At[4][2], B0[2][2], B1[2][2];
    const char* cA = (const char*)g.A + (size_t)cur.pm * tstep; const char* cB = (const char*)g.Bt + (size_t)cur.pn * tstep;
    S.a_ready(cur);
    if constexpr (SP2) {
        PG8_STAGE(PG8_SB(0, 0), cB, voffB); PG8_STAGE(PG8_SB(0, 1), cB + hstep, voffB); PG8_STAGE(PG8_SA(0, 0), cA, voffA); PG8_STAGE(PG8_SA(0, 1), cA + hstep, voffA);
        if (wr == 1) PG8_BAR;
        PG8_WAIT_V(2); PG8_BAR;
        PG8_STAGE(PG8_SB(1, 0), cB + kstep, voffB); PG8_STAGE(PG8_SA(1, 0), cA + kstep, voffA); PG8_STAGE(PG8_SB(1, 1), cB + hstep + kstep, voffB);
        PG8_WAIT_V(6); PG8_BAR;
    } else {
        PG8_STAGE(PG8_SB(0, 0), cB, voffB); PG8_STAGE(PG8_SA(0, 0), cA, voffA); PG8_STAGE(PG8_SB(0, 1), cB + hstep, voffB); PG8_STAGE(PG8_SA(0, 1), cA + hstep, voffA);
        if (wr == 1) PG8_BAR;
        PG8_WAIT_V(4); PG8_BAR;
        PG8_STAGE(PG8_SB(1, 0), cB + kstep, voffB); PG8_STAGE(PG8_SA(1, 0), cA + kstep, voffA); PG8_STAGE(PG8_SB(1, 1), cB + hstep + kstep, voffB);
        PG8_WAIT_V(6); PG8_BAR;
    }
    for (;;) {
        const bool has_next = S.next(ui + 1, nxt);
        const char* nA = has_next ? (const char*)g.A + (size_t)nxt.pm * tstep : cA; const char* nB = has_next ? (const char*)g.Bt + (size_t)nxt.pn * tstep : cB;
        PG8_KSTAMP_BEGIN();
        for (int t = 0; t < nt; t += 2) {
            const bool last = (t == nt - 2);
            const char* a1 = cA + (size_t)(t + 1) * kstep;
            const char* a2 = last ? nA : cA + (size_t)(t + 2) * kstep; const char* b2 = last ? nB : cB + (size_t)(t + 2) * kstep;
            const char* a3 = a2 + kstep; const char* b3 = b2 + kstep;
            PG8_KSTAMP_TRIP();
            if (last && has_next) S.a_ready(nxt);
            if constexpr (Epi::MID_T >= 0) { if (t == E.mid_t()) E.mid(acc, cur, wr, wc, fr, fq); }
            if constexpr (SP2) {
            PG8_LDB(B0, 0, 0); PG8_LDB(B1, 0, 1); PG8_SCHED; PG8_LDA(At, 0, 0); PG8_STAGE(PG8_SA(1, 1), a1 + hstep, voffA);
            PG8_WAIT_V(8); PG8_WAIT_L(0); PG8_BAR; PG8_MMA(0, 0, At, B0); PG8_MMA(0, 1, At, B1); PG8_BAR; PG8_SCHED;
            PG8_LDA(At, 0, 1); PG8_STAGE(PG8_SB(0, 0), b2, voffB); PG8_STAGE(PG8_SB(0, 1), b2 + hstep, voffB); PG8_STAGE(PG8_SA(0, 0), a2, voffA);
            PG8_WAIT_V(8); PG8_WAIT_L(0); PG8_BAR; PG8_MMA(1, 0, At, B0); PG8_MMA(1, 1, At, B1); PG8_BAR; PG8_SCHED;
            PG8_LDB(B0, 1, 0); PG8_LDB(B1, 1, 1); PG8_SCHED; PG8_LDA(At, 1, 0); PG8_STAGE(PG8_SA(0, 1), a2 + hstep, voffA);
            PG8_WAIT_V(8); PG8_WAIT_L(0); PG8_BAR; PG8_MMA(0, 0, At, B0); PG8_MMA(0, 1, At, B1); PG8_BAR; PG8_SCHED;
            PG8_LDA(At, 1, 1); PG8_STAGE(PG8_SB(1, 0), b3, voffB); PG8_STAGE(PG8_SB(1, 1), b3 + hstep, voffB); PG8_STAGE(PG8_SA(1, 0), a3, voffA);
            PG8_WAIT_V(8); PG8_WAIT_L(0); PG8_BAR; PG8_MMA(1, 0, At, B0); PG8_MMA(1, 1, At, B1); PG8_BAR; PG8_SCHED;
            } else {
            PG8_LDB(B0, 0, 0); PG8_SCHED; PG8_LDA(At, 0, 0); PG8_STAGE(PG8_SA(1, 1), a1 + hstep, voffA);
            PG8_WAIT_L(8); PG8_BAR; PG8_WAIT_L(0); PG8_MMA(0, 0, At, B0); PG8_BAR; PG8_SCHED;
            PG8_LDB(B1, 0, 1); PG8_STAGE(PG8_SB(0, 0), b2, voffB);
            PG8_BAR; PG8_WAIT_L(0); PG8_MMA(0, 1, At, B1); PG8_BAR;
            PG8_LDA(At, 0, 1); PG8_STAGE(PG8_SA(0, 0), a2, voffA);
            PG8_BAR; PG8_WAIT_L(0); PG8_MMA(1, 0, At, B0); PG8_BAR; PG8_SCHED;
            PG8_STAGE(PG8_SB(0, 1), b2 + hstep, voffB);
            PG8_WAIT_V(6); PG8_BAR; PG8_MMA(1, 1, At, B1); PG8_BAR;
            PG8_LDB(B0, 1, 0); PG8_SCHED; PG8_LDA(At, 1, 0); PG8_STAGE(PG8_SA(0, 1), a2 + hstep, voffA);
            PG8_WAIT_L(8); PG8_BAR; PG8_WAIT_L(0); PG8_MMA(0, 0, At, B0); PG8_BAR; PG8_SCHED;
            PG8_LDB(B1, 1, 1); PG8_STAGE(PG8_SB(1, 0), b3, voffB);
            PG8_BAR; PG8_WAIT_L(0); PG8_MMA(0, 1, At, B1); PG8_BAR;
            PG8_LDA(At, 1, 1); PG8_STAGE(PG8_SA(1, 0), a3, voffA);
            PG8_BAR; PG8_WAIT_L(0); PG8_MMA(1, 0, At, B0); PG8_BAR; PG8_SCHED;
            PG8_STAGE(PG8_SB(1, 1), b3 + hstep, voffB);
            PG8_WAIT_V(6); PG8_BAR; PG8_MMA(1, 1, At, B1); PG8_BAR;
            }
        }
        PG8_KSTAMP_END();
        if constexpr (ALIGN_EPI) { if (wr == 0) PG8_BAR; }
        if constexpr (!Epi::AFTER_DRAIN) { E(acc, cur, wr, wc, fr, fq); S.done(cur); }
        if (!has_next) break;
#pragma unroll
        for (int a = 0; a < 2; ++a)
#pragma unroll
            for (int b = 0; b < 2; ++b)
#pragma unroll
                for (int m = 0; m < 4; ++m)
#pragma unroll
                    for (int n = 0; n < 2; ++n) acc[a][b][m][n] = (f32x4){0.f, 0.f, 0.f, 0.f};
        cur = nxt; cA = nA; cB = nB; ++ui;
        if constexpr (ALIGN_EPI) { if (wr == 1) PG8_BAR; }
    }
    PG8_WAIT_V(0);
    if constexpr (!ALIGN_EPI) { if (wr == 0) PG8_BAR; }
    PG8_BAR;
    if constexpr (Epi::AFTER_DRAIN) { E.fused(acc, cur, wr, wc, fr, fq, lds, wid, lane); S.done(cur); }
#undef PG8_SA
#undef PG8_SB
#undef PG8_STAGE
#undef PG8_LDA
#undef PG8_LDB
#undef PG8_MMA
#undef PG8_WAIT_V
#undef PG8_WAIT_L
#undef PG8_BAR
#undef PG8_SCHED
}
}
#ifdef MK_STAMP_A
#define ATT_SUBSTAMP() do { if (tid == 0) ((ATT_LAS unsigned*)(lds + (155648 - 1024) + 64))[att_ns] = (unsigned)__builtin_amdgcn_s_memrealtime(); ++att_ns; } while (0)
#endif
#ifndef ATT_KVLD
#define ATT_KVLD(p) (*(p))
#endif
#ifndef ATT_SUBSTAMP
#define ATT_SUBSTAMP() do {} while (0)
#endif
namespace att {
typedef unsigned short bf16_t;
typedef short bf16x8 __attribute__((ext_vector_type(8)));
typedef short s16x4 __attribute__((ext_vector_type(4)));
typedef float f32x16 __attribute__((ext_vector_type(16)));
typedef float f32x2_t __attribute__((ext_vector_type(2)));
typedef __bf16 bf16x2_t __attribute__((ext_vector_type(2)));
typedef unsigned u32x4 __attribute__((ext_vector_type(4)));
typedef unsigned u32x2 __attribute__((ext_vector_type(2)));
#define ATT_LAS __attribute__((address_space(3)))
constexpr int T = 8192;
constexpr float LOG2E = 1.4426950408889634f;
constexpr float NEG_BIG = -1.0e30f;
constexpr int B_K = 0, B_VT = 49152, B_VT_PITCH = 784, B_TAB = B_VT + 64 * B_VT_PITCH  , B_TAB_N = 320;
constexpr int MISC = B_TAB + 4 * B_TAB_N * 4;
constexpr int A_TAB = MISC + 64;
constexpr int O_STAGE = A_TAB + 8192, O_STAGE_PITCH = 144, O_STAGE_WAVE = 32 * O_STAGE_PITCH;
static_assert(A_TAB % 16 == 0 && O_STAGE % 16 == 0, "attention LDS map");
__device__ __forceinline__ int kappa(int r) { return (r & 19) | ((r & 4) << 1) | ((r & 8) >> 1); }
__device__ __forceinline__ int kcol0(int i) { return (i & 7) + 16 * (i >> 3); }
__device__ __forceinline__ int crow(int i, int h) { return (i & 3) + 8 * (i >> 2) + 4 * h; }
__device__ __forceinline__ unsigned cvtpk(float lo, float hi) { f32x2_t v = {lo, hi}; bf16x2_t b = __builtin_convertvector(v, bf16x2_t); return __builtin_bit_cast(unsigned, b); }
__device__ __forceinline__ bf16x8 pack8(const float* e) { u32x4 p; p.x = cvtpk(e[0], e[1]); p.y = cvtpk(e[2], e[3]); p.z = cvtpk(e[4], e[5]); p.w = cvtpk(e[6], e[7]); return __builtin_bit_cast(bf16x8, p); }
__device__ __forceinline__ bf16x8 cat4(s16x4 a, s16x4 b) { return (bf16x8){a[0], a[1], a[2], a[3], b[0], b[1], b[2], b[3]}; }
__device__ __forceinline__ int clampi(int v, int lo, int hi) { return v < lo ? lo : (v > hi ? hi : v); }
__device__ __forceinline__ float wave_max(float v) {
#pragma unroll
    for (int o = 1; o < 64; o <<= 1) v = fmaxf(v, __shfl_xor(v, o));
    return v;
}
#define ATT_MFMA(a, b, c) __builtin_amdgcn_mfma_f32_32x32x16_bf16((a), (b), (c), 0, 0, 0)

struct Tensors {
    const bf16_t *QA, *KA, *VAT, *QB, *KB, *VBT; bf16_t *OA, *OB;
    const float *rpb, *qna, *kna, *qnb, *knb, *sink, *t5;
};

__device__ __forceinline__ int t5_bucket(int rel) {
    const int n = rel < 0 ? -rel : rel;
    const int large = 8 + (n >= 12) + (n >= 16) + (n >= 23) + (n >= 32) + (n >= 46) + (n >= 64) + (n >= 91);
    return (rel > 0 ? 16 : 0) + (n < 8 ? n : large);
}

template <class TokF> __device__ __forceinline__ void store_o(ATT_LAS unsigned char* stg, bf16_t* obase  , TokF tok, const f32x16& o0, const f32x16& o1, float il, int lane) {
    const int r = lane & 31, hi = lane >> 5;
#pragma unroll
    for (int g = 0; g < 4; ++g) {
        u32x2 w0, w1;
        w0.x = cvtpk(o0[4 * g] * il, o0[4 * g + 1] * il); w0.y = cvtpk(o0[4 * g + 2] * il, o0[4 * g + 3] * il);
        w1.x = cvtpk(o1[4 * g] * il, o1[4 * g + 1] * il); w1.y = cvtpk(o1[4 * g + 2] * il, o1[4 * g + 3] * il);
        *(ATT_LAS u32x2*)(stg + r * O_STAGE_PITCH + (8 * g + 4 * hi) * 2) = w0; *(ATT_LAS u32x2*)(stg + r * O_STAGE_PITCH + 64 + (8 * g + 4 * hi) * 2) = w1;
    }
#pragma unroll
    for (int i = 0; i < 4; ++i) { const int q = (lane >> 3) + 8 * i, c = lane & 7;
        const u32x4 v = *(const ATT_LAS u32x4*)(stg + q * O_STAGE_PITCH + c * 16);
        *(u32x4*)(obase + (size_t)tok(q) * 1024 + c * 8) = v; }
}

__device__ __forceinline__ void natten_quad(const Tensors& A, const ATT_LAS float* tab  , ATT_LAS unsigned char* stg  , int b, int h, int j, int v, int lane) {
    const int r = lane & 31, hi = lane >> 5;
    const int R0 = 4 * v, qc = 16 * j + (r & 15);
    const int kr_lo = clampi(R0 - 4, 0, 120), kr_hi = clampi(R0 - 1, 0, 120) + 7, nrows = kr_hi - kr_lo + 1;
    const int ss = clampi(16 * j - 8, 0, 32), ws = clampi(qc - 8, 0, 48);
    const int qrow0 = R0 + (r >> 4), qrow1 = R0 + 2 + (r >> 4);
    const int rsq0 = clampi(qrow0 - 4, 0, 120), rsq1 = clampi(qrow1 - 4, 0, 120);
    const int lo0 = clampi(R0 - 4, 0, 120), hi0 = clampi(R0 - 3, 0, 120) + 8, lo1 = clampi(R0 - 2, 0, 120), hi1 = clampi(R0 - 1, 0, 120) + 8;
    const size_t mq0 = (size_t)b * T + qrow0 * 64 + qc, mq1 = mq0 + 128;
    bf16x8 qf0[4], qf1[4];
#pragma unroll
    for (int s = 0; s < 4; ++s) { qf0[s] = __builtin_nontemporal_load((const bf16x8*)(A.QA + mq0 * 512 + h * 64 + 16 * s + 8 * hi));
                                  qf1[s] = __builtin_nontemporal_load((const bf16x8*)(A.QA + mq1 * 512 + h * 64 + 16 * s + 8 * hi)); }
    f32x16 oa0, oa1, ob0, ob1;
#pragma unroll
    for (int i = 0; i < 16; ++i) { oa0[i] = 0.f; oa1[i] = 0.f; ob0[i] = 0.f; ob1[i] = 0.f; }
    float lsa = 0.f, lsb = 0.f;
    const int cmask0 = ss + 8 * hi - ws;
    const int dcol0 = ss + 8 * hi - qc + 31;
    const int tk0 = kr_lo * 64 + ss + kappa(r);
    const bf16_t* kbase = A.KA + ((size_t)(b * 1024 * 8 + h) * 64 + hi * 8 + (tk0 & 7)) * 8 + (size_t)(tk0 >> 3) * (8 * 512);
    const bf16_t* vbase = A.VAT + ((size_t)(b * 1024 * 8 + h) * 64 + r) * 8 + (size_t)((kr_lo * 64 + ss + 8 * hi) >> 3) * (8 * 512);
    bf16x8 ka[4], va[4], kb[4], vb[4];
#define ATT_LOADKV(KF, VF, kr_) do { const int krc_ = (kr_) < nrows ? (kr_) : nrows - 1; const size_t ko_ = (size_t)krc_ * (8 * 8 * 512); \
        _Pragma("unroll") for (int s = 0; s < 4; ++s) KF[s] = ATT_KVLD((const bf16x8*)(kbase + ko_ + s * 128)); \
        _Pragma("unroll") for (int dt = 0; dt < 2; ++dt) _Pragma("unroll") for (int s2 = 0; s2 < 2; ++s2) VF[dt * 2 + s2] = ATT_KVLD((const bf16x8*)(vbase + ko_ + dt * 256 + s2 * (2 * 8 * 512))); } while (0)
#define ATT_BLOCK(KF, VF, QF, O0, O1, LS, QROW, RSQ) do { \
        const bool rowok = (krow >= (RSQ)) && (krow < (RSQ) + 8); \
        const ATT_LAS float* tp = tab + (rowok ? (krow - (QROW) + 7) : 15) * 64 + dcol0; \
        float bv[16]; _Pragma("unroll") for (int i = 0; i < 16; ++i) bv[i] = tp[kcol0(i)]; \
        f32x16 x; _Pragma("unroll") for (int i = 0; i < 16; ++i) x[i] = 0.f; \
        _Pragma("unroll") for (int s = 0; s < 4; ++s) x = ATT_MFMA(KF[s], QF[s], x); \
        float e[16]; \
        _Pragma("unroll") for (int i = 0; i < 16; ++i) { const float v_ = __builtin_amdgcn_exp2f(x[i] + bv[i]); e[i] = ((unsigned)(cmask0 + kcol0(i)) < 16u) ? v_ : 0.f; LS += e[i]; } \
        _Pragma("unroll") for (int s2 = 0; s2 < 2; ++s2) { const bf16x8 xs = pack8(e + 8 * s2); O0 = ATT_MFMA(VF[s2], xs, O0); O1 = ATT_MFMA(VF[2 + s2], xs, O1); } } while (0)
#define ATT_ROW(KF, VF, kr_) do { const int krow = kr_lo + (kr_); \
        if (krow >= lo0 && krow < hi0) ATT_BLOCK(KF, VF, qf0, oa0, oa1, lsa, qrow0, rsq0);        \
        if (krow >= lo1 && krow < hi1) ATT_BLOCK(KF, VF, qf1, ob0, ob1, lsb, qrow1, rsq1); } while (0)
    ATT_LOADKV(ka, va, 0);
    for (int kr = 0; kr < nrows; kr += 2) {
        ATT_LOADKV(kb, vb, kr + 1);
        ATT_ROW(ka, va, kr);
        ATT_LOADKV(ka, va, kr + 2);
        ATT_ROW(kb, vb, kr + 1);
    }
#undef ATT_ROW
#undef ATT_LOADKV
#undef ATT_BLOCK
    lsa += __shfl_xor(lsa, 32); lsb += __shfl_xor(lsb, 32);
    { const size_t tb0 = (size_t)b * T + R0 * 64 + 16 * j;
      store_o(stg, A.OA + h * 64, [&](int q) { return tb0 + (q >> 4) * 64 + (q & 15); }, oa0, oa1, 1.0f / lsa, lane);
      store_o(stg, A.OA + h * 64, [&](int q) { return tb0 + 128 + (q >> 4) * 64 + (q & 15); }, ob0, ob1, 1.0f / lsb, lane); }
}

__device__ __forceinline__ void swa_stage(ATT_LAS unsigned char* lds, const Tensors& A, int b, int n, int kvh, int tid) {
#pragma unroll
    for (int i = 0; i < 6; ++i) { const int c = tid + 512 * i, tbw = c >> 6, ch = (c >> 3) & 7, ti = c & 7, w = tbw * 8 + ti; const int tok = clampi(n * 128 - 128 + w, 0, T - 1);
        const u32x4 v = *(const u32x4*)(A.KB + ((size_t)((b * 1024 + (tok >> 3)) * 2 + kvh) * 64 + ch * 8 + (tok & 7)) * 8);
        *(ATT_LAS u32x4*)(lds + B_K + w * 128 + ((ch ^ ((w >> 1) & 7)) << 4)) = v; }
#pragma unroll
    for (int i = 0; i < 6; ++i) { const int c = tid + 512 * i, tbw = c >> 6, d = c & 63; const int tb = n * 16 - 16 + tbw;
        u32x4 v = (u32x4){0u, 0u, 0u, 0u};
        if (tb >= 0 && tb < T / 8) v = *(const u32x4*)(A.VBT + ((size_t)((b * 1024 + tb) * 2 + kvh) * 64 + d) * 8);
        *(ATT_LAS u32x4*)(lds + B_VT + d * B_VT_PITCH + tbw * 16) = v; }
}
__device__ __forceinline__ void swa_compute(ATT_LAS unsigned char* lds, ATT_LAS unsigned char* stg  , const Tensors& A, int b, int n, int kvh, int g, int sb0, int lane) {
    const ATT_LAS float* misc = (const ATT_LAS float*)(lds + MISC);
    const int head = kvh * 4 + g, r = lane & 31, hi = lane >> 5;
    const ATT_LAS float* tabg = (const ATT_LAS float*)(lds + B_TAB) + g * B_TAB_N;
    const int kap = kappa(r), kswz = (kap >> 1) & 7;
#pragma unroll 1
    for (int sb = sb0; sb < sb0 + 2; ++sb) {
        const size_t mq = (size_t)b * T + n * 128 + 32 * sb + r;
        bf16x8 qf[4];
#pragma unroll
        for (int s = 0; s < 4; ++s) qf[s] = __builtin_nontemporal_load((const bf16x8*)(A.QB + mq * 512 + head * 64 + 16 * s + 8 * hi));
        f32x16 o0, o1;
#pragma unroll
        for (int i = 0; i < 16; ++i) { o0[i] = 0.f; o1[i] = 0.f; }
        float lsum = 0.f;
        const int kt_lo = sb > ((n == 0) ? 4 : 0) ? sb : ((n == 0) ? 4 : 0);
        const int kt_hi = (sb + 8) < ((n == T / 128 - 1) ? 7 : 11) ? (sb + 8) : ((n == T / 128 - 1) ? 7 : 11);
        for (int kt = kt_lo; kt <= kt_hi; ++kt) {
            const ATT_LAS float* tp = tabg + 32 * (kt - sb) + 32 - r + 8 * hi;
            const ATT_LAS unsigned char* kp = lds + B_K + (32 * kt + kap) * 128;
            bf16x8 kf[4];
#pragma unroll
            for (int s = 0; s < 4; ++s) kf[s] = *(const ATT_LAS bf16x8*)(kp + (((2 * s + hi) ^ kswz) << 4));
            float bv[16];
#pragma unroll
            for (int i = 0; i < 16; ++i) bv[i] = tp[kcol0(i)];
            f32x16 x;
#pragma unroll
            for (int i = 0; i < 16; ++i) x[i] = 0.f;
#pragma unroll
            for (int s = 0; s < 4; ++s) x = ATT_MFMA(kf[s], qf[s], x);
            float e[16];
#pragma unroll
            for (int i = 0; i < 16; ++i) { e[i] = __builtin_amdgcn_exp2f(x[i] + bv[i]); lsum += e[i]; }
            const ATT_LAS unsigned char* vp = lds + B_VT + r * B_VT_PITCH + (32 * kt + 8 * hi) * 2;
#pragma unroll
            for (int s2 = 0; s2 < 2; ++s2) { const bf16x8 xs = pack8(e + 8 * s2);
                const bf16x8 a0 = *(const ATT_LAS bf16x8*)(vp + 32 * s2), c0 = *(const ATT_LAS bf16x8*)(vp + 32 * B_VT_PITCH + 32 * s2);
                o0 = ATT_MFMA(a0, xs, o0); o1 = ATT_MFMA(c0, xs, o1); }
        }
        lsum += __shfl_xor(lsum, 32);
        lsum += misc[12 + g];
        { const size_t tb0 = (size_t)b * T + n * 128 + 32 * sb; store_o(stg, A.OB + head * 64, [&](int q) { return tb0 + q; }, o0, o1, 1.0f / lsum, lane); }
    }
}

constexpr int TAB_A_FLOATS = 8 * 16 * 64, TAB_B_FLOATS = 8 * B_TAB_N, TAB_FLOATS = TAB_A_FLOATS + TAB_B_FLOATS + 8;
__device__ __forceinline__ void build_tables(ATT_LAS unsigned char* lds, float* tabs, const Tensors& A, int h, int tid, int wid, int lane) {
    ATT_LAS float* misc = (ATT_LAS float*)lds;
    if (wid == 0) { float mx = 0.f;
        for (int i = lane; i < 15 * 31; i += 64) mx = fmaxf(mx, fabsf(A.rpb[i * 8 + h]));
        mx = wave_max(mx); const float gq = wave_max(fabsf(A.qna[lane])), gk = wave_max(fabsf(A.kna[lane]));
        if (lane == 0) misc[0] = 8.0f * gq * gk * 1.02f + mx;
    } else if (wid == 1) { float mx = lane < 32 ? fabsf(A.t5[lane * 8 + h]) : 0.f;
        mx = wave_max(mx); const float gq = wave_max(fabsf(A.qnb[lane])), gk = wave_max(fabsf(A.knb[lane]));
        const float sk = A.sink[h], M = fmaxf(8.0f * gq * gk * 1.02f + mx, sk);
        if (lane == 0) { misc[1] = M; tabs[TAB_A_FLOATS + TAB_B_FLOATS + h] = __builtin_amdgcn_exp2f((sk - M) * LOG2E); }
    }
    __syncthreads();
    for (int idx = tid; idx < 16 * 64; idx += 512) { const int row = idx >> 6, dc = (idx & 63) - 16; float v = NEG_BIG;
        if (row < 15 && dc >= 0 && dc <= 30) v = (A.rpb[(row * 31 + dc) * 8 + h] - misc[0]) * LOG2E;
        tabs[h * 1024 + idx] = v; }
    for (int idx = tid; idx < B_TAB_N; idx += 512) { const int rel = idx - 160; float v = NEG_BIG;
        if (rel >= -128 && rel <= 128) v = (A.t5[t5_bucket(rel) * 8 + h] - misc[1]) * LOG2E;
        tabs[TAB_A_FLOATS + h * B_TAB_N + idx] = v; }
    __syncthreads();
}

__device__ __forceinline__ void attn_phase(ATT_LAS unsigned char* lds, const Tensors& A, const float* tabs, int vcu, int tid, int wid, int lane) {
    int att_ns = 0; (void)att_ns;
    ATT_LAS float* misc = (ATT_LAS float*)(lds + MISC);
    const int b = vcu >> 7, v = (vcu & 127) >> 2, hp = vcu & 3, n = 2 * v + (hp & 1), kvh = hp >> 1;
    {
        ((ATT_LAS u32x4*)(lds + A_TAB))[tid] = ((const u32x4*)(tabs + 2 * hp * 1024))[tid];
        if (tid < B_TAB_N) ((ATT_LAS u32x4*)(lds + B_TAB))[tid] = ((const u32x4*)(tabs + TAB_A_FLOATS + 4 * kvh * B_TAB_N))[tid];
        if (tid < 4) misc[12 + tid] = tabs[TAB_A_FLOATS + TAB_B_FLOATS + 4 * kvh + tid];
    }
    swa_stage(lds, A, b, n, kvh, tid);
    __syncthreads();
    ATT_SUBSTAMP();
    natten_quad(A, (const ATT_LAS float*)(lds + A_TAB) + (wid & 1) * 1024, lds + O_STAGE + wid * O_STAGE_WAVE, b, 2 * hp + (wid & 1), wid >> 1, v, lane);
    ATT_SUBSTAMP();
    swa_compute(lds, lds + O_STAGE + wid * O_STAGE_WAVE, A, b, n, kvh, wid & 3, 2 * (wid >> 2), lane);
    __syncthreads();
}
}

#ifndef PG8_SP2
#define PG8_SP2 true
#endif
#ifndef PG8_ALIGN
#define PG8_ALIGN true
#endif

#ifndef MK_REPEAT
#define MK_REPEAT (-1)
#endif
#ifndef MK_BF16_RESID
#define MK_BF16_RESID 1
#endif
#ifndef MK_CODE_PREFETCH
#define MK_CODE_PREFETCH 0
#endif
#define MK_CODE_BYTES 94208
#ifndef MK_WGM_P1
#define MK_WGM_P1 4
#endif
#ifndef MK_WGM_P5
#define MK_WGM_P5 4
#endif
#ifndef MK_HOOK4
#define MK_HOOK4(v) (2 + 2 * ((v) % 6))
#endif
#ifndef MK_HOOK6
#define MK_HOOK6(v) (2 + 2 * ((v) % 20))
#endif
#ifndef MK_GROUP_BAR
#define MK_GROUP_BAR 1
#endif
constexpr int NWAVES = 8;
constexpr int N_PHASES = 7;
constexpr int BATCH = 2, T = 8192, D = 1024, M = BATCH * T, FF = 2816, NIN = 4352, AW = 512;
constexpr size_t MiB = 1u << 20;
constexpr size_t WS_CTL = 0, CTL_ZERO_BYTES = 1 * MiB;
constexpr size_t WS_WIN = 1 * MiB;
constexpr size_t WS_WB = WS_WIN + (size_t)NIN * D * 2;
constexpr size_t WS_WO = WS_WB + (size_t)D * D * 2;
constexpr size_t WS_WGU = WS_WO + (size_t)D * D * 2;
constexpr size_t WS_WD = WS_WGU + (size_t)2 * FF * D * 2;
constexpr size_t WS_WEND = WS_WD + (size_t)D * FF * 2;
constexpr size_t WS_RS1 = 30 * MiB, WS_SS = 30 * MiB + 512 * 1024;
constexpr size_t WS_TABS = 31 * MiB;
constexpr size_t WS_XN = 32 * MiB;
constexpr size_t WS_Y = WS_XN;
constexpr size_t WS_QA = 64 * MiB, WS_KA = 80 * MiB, WS_VAT = 96 * MiB, WS_QB = 112 * MiB, WS_KB = 128 * MiB, WS_VBT = 132 * MiB;
constexpr size_t WS_GATE = 136 * MiB;
constexpr size_t WS_OA = 200 * MiB, WS_OB = WS_OA + 512 * 2;
constexpr size_t WS_X1B = WS_OA;
constexpr size_t WS_U = 64 * MiB;
constexpr size_t WS_END = 256 * MiB;
static_assert(WS_WEND <= WS_RS1 && WS_SS + (size_t)M * 16 <= WS_XN && WS_U + (size_t)M * FF * 2 <= WS_OA && WS_OA + (size_t)M * D * 2 <= WS_END, "d_ws map");
constexpr int CW_TMO = 0, CW_CODE = 1, CW_BAR = 4096, CW_GRP = 12288, CW_XCC = 8192;

constexpr int RING_OFF = 0, RING_BYTES = 131072;
constexpr int LDS_BYTES = 155648;
constexpr int LDSCTL_OFF = LDS_BYTES - 1024, MISC_OFF = LDSCTL_OFF + 320;
constexpr int EPI_TAB_OFF = RING_BYTES;
static_assert(MISC_OFF + 128 <= LDS_BYTES && EPI_TAB_OFF + 8192 <= LDSCTL_OFF && att::O_STAGE + 8 * att::O_STAGE_WAVE <= LDSCTL_OFF, "LDS map");

#define GAS __attribute__((address_space(1)))
#define LAS __attribute__((address_space(3)))
typedef unsigned short bf16;
typedef unsigned v4u __attribute__((ext_vector_type(4)));
typedef float f32x4 __attribute__((ext_vector_type(4)));
typedef short bf16x8 __attribute__((ext_vector_type(8)));
typedef GAS unsigned gu32;
typedef GAS unsigned long long gu64;
#define RLX_AGENT __ATOMIC_RELAXED, __HIP_MEMORY_SCOPE_AGENT
#define LDS_WAIT() asm volatile("s_waitcnt lgkmcnt(0)" ::: "memory")
#define VM_WAIT() asm volatile("s_waitcnt vmcnt(0)" ::: "memory")
__device__ __forceinline__ unsigned long long rt() { return __builtin_amdgcn_s_memrealtime(); }
__device__ __forceinline__ unsigned f2bf(float f) { unsigned u = __builtin_bit_cast(unsigned, f); return (u + 0x7fffu + ((u >> 16) & 1u)) >> 16; }
__device__ __forceinline__ unsigned pk2(float lo, float hi) { return f2bf(lo) | (f2bf(hi) << 16); }
#define XB_TMO      128
#define XB_XCNT(j)  (256  + 64 * (j))
#define XB_XSUB(j)  (1280 + 64 * (j))
#define XB_XGEN(j)  (2304 + 64 * (j))
#define XB_TOP      3328
#define XB_TOPGEN   3392
#define XCD_BAR_WORDS 3456
#define XB_SPIN_CAP (1u << 18)

__device__ __forceinline__ unsigned xb_ld(unsigned* p)              { return __hip_atomic_load(p, __ATOMIC_RELAXED, __HIP_MEMORY_SCOPE_AGENT); }
__device__ __forceinline__ unsigned xb_add(unsigned* p, unsigned v) { return __hip_atomic_fetch_add(p, v, __ATOMIC_RELAXED, __HIP_MEMORY_SCOPE_AGENT); }
__device__ __forceinline__ unsigned xb_xcc_id() { return (unsigned)__builtin_amdgcn_s_getreg((3 << 11) | 20) & 0xFu; }
#define XB_SPIN(cond, bar) do { unsigned _sp = 0; while (cond) { __builtin_amdgcn_s_sleep(1); \
    if ((++_sp & 255u) == 0u) { if (xb_ld(&(bar)[XB_TMO])) break; if (_sp > XB_SPIN_CAP) { atomicAdd(&(bar)[XB_TMO], 1u); break; } } } } while (0)

struct XcdBarrier {
    unsigned* bar; unsigned x;
    volatile LAS unsigned* st;
};

__device__ __forceinline__ XcdBarrier xcd_barrier_post(unsigned* bar, volatile LAS unsigned* st) {
    XcdBarrier b; b.bar = bar; b.x = xb_xcc_id(); b.st = st;
    if (threadIdx.x == 0) (void)xb_add(&bar[XB_XCNT(b.x)], 1u);
    return b;
}
__device__ __forceinline__ void xcd_barrier_complete(unsigned* bar, unsigned x, unsigned& nloc, unsigned& nx) {
    const unsigned G = gridDim.x * gridDim.y * gridDim.z;
    unsigned sum, cnt, mine, sp = 0u;
    for (;;) {
        sum = 0u; cnt = 0u; mine = 0u;
#pragma unroll
        for (unsigned j = 0; j < 16; ++j) { const unsigned c = xb_ld(&bar[XB_XCNT(j)]); sum += c; cnt += (c > 0u) ? 1u : 0u; mine = (j == x) ? c : mine; }
        if (sum == G) break;
        __builtin_amdgcn_s_sleep(1);
        if ((++sp & 255u) == 0u) { if (xb_ld(&bar[XB_TMO])) break; if (sp > XB_SPIN_CAP) { atomicAdd(&bar[XB_TMO], 1u); break; } }
    }
    nloc = mine > 0u ? mine : 1u; nx = cnt > 0u ? cnt : 1u;
}

__device__ __forceinline__ void xcd_barrier(const XcdBarrier& b) {
    asm volatile("s_waitcnt vmcnt(0)" ::: "memory");
    __syncthreads();
    if (threadIdx.x == 0) {
        unsigned* bar = b.bar;
        __builtin_amdgcn_s_waitcnt(0);
        unsigned nloc = b.st[0], nx = b.st[1];
        if (nloc == 0u) { xcd_barrier_complete(bar, b.x, nloc, nx); b.st[0] = nloc; b.st[1] = nx; }
        const unsigned old = xb_add(&bar[XB_XSUB(b.x)], 1u);
        const unsigned gen = old / nloc;
        if (old + 1u == (gen + 1u) * nloc) {
            __builtin_amdgcn_fence(__ATOMIC_RELEASE, "agent");
            asm volatile("s_waitcnt vmcnt(0)" ::: "memory");
            const unsigned og = xb_add(&bar[XB_TOP], 1u);
            const unsigned tg = og / nx;
            if (og + 1u == (tg + 1u) * nx) xb_add(&bar[XB_TOPGEN], 1u);
            else XB_SPIN(xb_ld(&bar[XB_TOPGEN]) == tg, bar);
            __builtin_amdgcn_fence(__ATOMIC_ACQUIRE, "agent");
            xb_add(&bar[XB_XGEN(b.x)], 1u);
            asm volatile("s_waitcnt vmcnt(0)" ::: "memory");
        } else {
            XB_SPIN(xb_ld(&bar[XB_XGEN(b.x)]) == gen, bar);
            __builtin_amdgcn_fence(__ATOMIC_ACQUIRE, "agent");
            asm volatile("s_waitcnt vmcnt(0)" ::: "memory");
        }
    }
    __syncthreads();
}


__device__ __forceinline__ void group_barrier(gu32* cnt, unsigned target, gu32* tmo) {
    asm volatile("s_waitcnt vmcnt(0)" ::: "memory");
    __syncthreads();
    if (threadIdx.x == 0) {
        (void)__hip_atomic_fetch_add(cnt, 1u, RLX_AGENT);
        unsigned sp = 0u;
        while (__hip_atomic_load(cnt, RLX_AGENT) < target) { __builtin_amdgcn_s_sleep(1);
            if ((++sp & 255u) == 0u) { if (__hip_atomic_load(tmo, RLX_AGENT)) break; if (sp > (1u << 18)) { __hip_atomic_store(tmo, 1u, RLX_AGENT); break; } } }
        __builtin_amdgcn_fence(__ATOMIC_ACQUIRE, "agent");
        asm volatile("s_waitcnt vmcnt(0)" ::: "memory");
    }
    __syncthreads();
}

struct Frame {
    LAS unsigned char* lds; volatile LAS unsigned* MISC; gu32* ctl;
    int tid, lane, wave, vcu, G;
};
struct Args { const float* in[17]; float* out; unsigned char* ws; int ph_lo, ph_hi; };
static_assert(sizeof(Args) == 17 * 8 + 8 + 8 + 8, "Args has no padding");

__device__ __forceinline__ float wave_sum(float v) {
#pragma unroll
    for (int o = 1; o < 64; o <<= 1) v += __shfl_xor(v, o);
    return v;
}
__device__ __forceinline__ const float* OPQ(const float* p) { asm volatile("" : "+s"(p)); return p; }
struct P0Item { const float* W; bf16* WT; const float* kscale; int ldk, N, k0, n0, drow0, kofs; };
__device__ __forceinline__ void p0_item_load(const P0Item& it, f32x4 (&v)[8], int lane) {
    const float* wp = it.W + (size_t)(it.k0 + (lane >> 3)) * it.N + it.n0 + 4 * (lane & 7);
#pragma unroll
    for (int i = 0; i < 8; ++i) v[i] = __builtin_nontemporal_load((const GAS f32x4*)(wp + (size_t)(8 * i) * it.N));
    if (it.kscale) {
#pragma unroll
        for (int i = 0; i < 8; ++i) v[i] = v[i] * it.kscale[it.k0 + (lane >> 3) + 8 * i];
    }
}
__device__ __forceinline__ void p0_item_finish(const P0Item& it, const f32x4 (&v)[8], LAS float* scr, int lane) {
#pragma unroll
    for (int i = 0; i < 8; ++i) { LAS float* d = scr + ((lane >> 3) + 8 * i) * 33 + 4 * (lane & 7); d[0] = v[i].x; d[1] = v[i].y; d[2] = v[i].z; d[3] = v[i].w; }
    LDS_WAIT(); asm volatile("" ::: "memory");
    const int c = lane & 7;
#pragma unroll
    for (int j = 0; j < 4; ++j) { const int n = (lane >> 3) + 8 * j; const LAS float* s = scr + (8 * c) * 33 + n;
        v4u o; o.x = pk2(s[0 * 33], s[1 * 33]); o.y = pk2(s[2 * 33], s[3 * 33]); o.z = pk2(s[4 * 33], s[5 * 33]); o.w = pk2(s[6 * 33], s[7 * 33]);
        *(GAS v4u*)(it.WT + (size_t)(it.drow0 + n) * it.ldk + it.kofs + it.k0 + 8 * c) = o; }
    LDS_WAIT(); asm volatile("" ::: "memory");
}
__device__ __forceinline__ P0Item p0_decode(const Args& a, int r) {
    unsigned char* ws = a.ws; P0Item it; it.kofs = 0; it.kscale = nullptr;
    constexpr int I_IN = (D / 64) * (NIN / 32), I_BR = (AW / 64) * (D / 32), I_O = (D / 64) * (D / 32), I_GU = (D / 64) * (FF / 32);
    if (r < I_IN) { const int nblk = NIN / 32, kb = r / nblk, nb = r % nblk, n0 = 32 * nb;
        const int within = n0 & 255; int drow0 = (n0 & ~255) + 128 * ((within >> 5) & 1) + 32 * (within >> 6);
        if (n0 >= 2304) { const int gb = n0 >= 3328 ? 1 : 0, c = n0 - 2304 - 1024 * gb; drow0 = 256 * (9 + (c >> 7)) + 128 * gb + (c & 127); }
        it.W = OPQ(a.in[2]); it.WT = (bf16*)(ws + WS_WIN); it.ldk = D; it.N = NIN; it.k0 = 64 * kb; it.n0 = n0; it.drow0 = drow0; return it; } r -= I_IN;
    if (r < 2 * I_BR) { const int second = r >= I_BR ? 1 : 0; if (second) r -= I_BR; const int nblk = D / 32, kb = r / nblk, nb = r % nblk;
        it.W = second ? OPQ(a.in[11]) : OPQ(a.in[10]); it.WT = (bf16*)(ws + WS_WB); it.ldk = D; it.N = D; it.k0 = 64 * kb; it.n0 = 32 * nb; it.drow0 = 32 * nb; it.kofs = second ? AW : 0; return it; } r -= 2 * I_BR;
    if (r < I_O) { const int nblk = D / 32, kb = r / nblk, nb = r % nblk;
        it.W = OPQ(a.in[12]); it.WT = (bf16*)(ws + WS_WO); it.ldk = D; it.N = D; it.k0 = 64 * kb; it.n0 = 32 * nb; it.drow0 = 32 * nb; return it; } r -= I_O;
    if (r < 2 * I_GU) { const int up = r >= I_GU ? 1 : 0; if (up) r -= I_GU; const int nblk = FF / 32, kb = r / nblk, nb = r % nblk, n0 = 32 * nb;
        it.W = up ? OPQ(a.in[15]) : OPQ(a.in[14]); it.WT = (bf16*)(ws + WS_WGU); it.ldk = D; it.N = FF; it.k0 = 64 * kb; it.n0 = n0; it.drow0 = 256 * (n0 >> 7) + 128 * up + (n0 & 127); if (MK_BF16_RESID) it.kscale = OPQ(a.in[13]); return it; } r -= 2 * I_GU;
    { const int nblk = D / 32, kb = r / nblk, nb = r % nblk;
      it.W = OPQ(a.in[16]); it.WT = (bf16*)(ws + WS_WD); it.ldk = FF; it.N = D; it.k0 = 64 * kb; it.n0 = 32 * nb; it.drow0 = 32 * nb; return it; }
}
__device__ __forceinline__ void p0_prologue(Frame& F, const Args& a, int item_lo, int item_hi, int gw, int NGW, bool rows) {
    LAS float* scr = (LAS float*)(F.lds + RING_OFF + F.wave * 16384);
    constexpr int I_IN = (D / 64) * (NIN / 32), I_BR = (AW / 64) * (D / 32), I_O = (D / 64) * (D / 32), I_GU = (D / 64) * (FF / 32), I_D = (FF / 64) * (D / 32);
    {
        f32x4 vc[8], vn[8];
        int it = gw >= 0 ? item_lo + gw : item_hi;
        P0Item cur = p0_decode(a, it < item_hi ? it : 0);
        if (it < item_hi) p0_item_load(cur, vc, F.lane);
        while (it < item_hi) {
            const int nx = it + NGW; const bool more = nx < item_hi;
            const P0Item nxt = p0_decode(a, more ? nx : 0);
            if (more) p0_item_load(nxt, vn, F.lane);
            p0_item_finish(cur, vc, scr, F.lane);
#pragma unroll
            for (int i = 0; i < 8; ++i) vc[i] = vn[i];
            cur = nxt; it = nx;
        }
    }
    if (!rows) return;
    const float* x = a.in[0]; const float* g = a.in[1]; bf16* XN = (bf16*)(a.ws + WS_XN);
    const GAS f32x4* gr = (const GAS f32x4*)g + F.lane;
    for (int m = gw; m < M; m += 4 * NGW) {
        f32x4 v[4][4];
#pragma unroll
        for (int q = 0; q < 4; ++q) { const GAS f32x4* xr = (const GAS f32x4*)(x + (size_t)(m + q * NGW) * D) + F.lane;
#pragma unroll
            for (int j = 0; j < 4; ++j) v[q][j] = __builtin_nontemporal_load(xr + 64 * j); }
        f32x4 gg[4];
#pragma unroll
        for (int j = 0; j < 4; ++j) gg[j] = gr[64 * j];
#pragma unroll
        for (int q = 0; q < 4; ++q) { float s = 0.f;
#pragma unroll
            for (int j = 0; j < 4; ++j) s += (v[q][j].x * v[q][j].x + v[q][j].y * v[q][j].y) + (v[q][j].z * v[q][j].z + v[q][j].w * v[q][j].w);
            const float rs = 1.0f / sqrtf(wave_sum(s) * (1.f / D) + 1e-6f);
            GAS unsigned long long* o8 = (GAS unsigned long long*)(XN + (size_t)(m + q * NGW) * D) + F.lane;
#pragma unroll
            for (int j = 0; j < 4; ++j) o8[64 * j] = (unsigned long long)pk2(v[q][j].x * rs * gg[j].x, v[q][j].y * rs * gg[j].y) | ((unsigned long long)pk2(v[q][j].z * rs * gg[j].z, v[q][j].w * rs * gg[j].w) << 32); }
    }
}

__global__ void __launch_bounds__(NWAVES * 64, 2) skel_fwd(Args args) {
    extern __shared__ __attribute__((aligned(16))) unsigned char lds[];
    Frame F;
    F.lds = (LAS unsigned char*)lds;
    F.MISC = (volatile LAS unsigned*)(F.lds + MISC_OFF);
    F.tid = threadIdx.x; F.lane = F.tid & 63; F.wave = __builtin_amdgcn_readfirstlane(F.tid >> 6);
    F.G = gridDim.x; { const int bx = blockIdx.x; F.vcu = (F.G % 8 == 0) ? (bx % 8) * (F.G / 8) + bx / 8 : bx; }
    unsigned char* ws = args.ws;
    F.ctl = (gu32*)(ws + WS_CTL);
    for (int u = F.tid; u < (LDS_BYTES - LDSCTL_OFF) / 4; u += NWAVES * 64) ((LAS unsigned*)(F.lds + LDSCTL_OFF))[u] = 0u;
    __syncthreads();
    const int lo = args.ph_lo, hi = args.ph_hi;
    if (F.tid == 0) __hip_atomic_store(F.ctl + CW_XCC + blockIdx.x, xb_xcc_id() + 1u, RLX_AGENT);
#if MK_CODE_PREFETCH
    unsigned long long pc0_; asm volatile("s_getpc_b64 %0" : "=s"(pc0_));
    const char* const code_slice = (const char*)pc0_ + (size_t)(blockIdx.x >> 3) * (MK_CODE_BYTES / 32) + 64 * F.lane;
#define CODE_TOUCH() do { if (F.wave == 0 && 64 * F.lane < MK_CODE_BYTES / 32) { unsigned cw_ = __builtin_nontemporal_load((const unsigned*)code_slice); asm volatile("" :: "v"(cw_)); } } while (0)
#else
#define CODE_TOUCH() do {} while (0)
#endif
#ifdef MK_STAMP_A
    unsigned long long ts_prev = __builtin_amdgcn_s_memrealtime(); const unsigned long long ts0 = ts_prev; unsigned enc_a = 0, enc_b = 0; int ts_n = 0;
#define STAMP() do { const unsigned long long now_ = __builtin_amdgcn_s_memrealtime(); const unsigned d_ = (unsigned)(now_ - ts_prev); if (ts_n == MK_STAMP_A) enc_a = d_; if (ts_n == MK_STAMP_B) enc_b = d_; ts_prev = now_; ++ts_n; } while (0)
#else
#define STAMP() do {} while (0)
#endif
    const bool multi = (hi - lo) > 1;
    XcdBarrier bar; bar.bar = (unsigned*)(F.ctl + CW_BAR); bar.x = 0; bar.st = nullptr;
    if (multi) bar = xcd_barrier_post((unsigned*)(F.ctl + CW_BAR), F.MISC + 8);
#define IN(k) (lo <= (k) && (k) < hi)
#define BOTH(k) (IN(k) && IN((k) + 1))
#define GRID_BAR() do { CODE_TOUCH(); xcd_barrier(bar); } while (0)
    unsigned grp_n = 0;
    bool grp_local = false;
#if MK_GROUP_BAR
#define GROUP_BAR() do { if (grp_local) { ++grp_n; group_barrier(F.ctl + CW_GRP + 64 * (blockIdx.x & 7), grp_n * (unsigned)(F.G >> 3), F.ctl + CW_TMO); } else GRID_BAR(); } while (0)
#else
#define GROUP_BAR() GRID_BAR()
#endif
    bf16* const WIN = (bf16*)(ws + WS_WIN); bf16* const WB = (bf16*)(ws + WS_WB); bf16* const WO = (bf16*)(ws + WS_WO);
    bf16* const WGU = (bf16*)(ws + WS_WGU); bf16* const WD = (bf16*)(ws + WS_WD);
    bf16* const XN = (bf16*)(ws + WS_XN); bf16* const Y = (bf16*)(ws + WS_Y);
    bf16* const QA = (bf16*)(ws + WS_QA); bf16* const KA = (bf16*)(ws + WS_KA); bf16* const VAT = (bf16*)(ws + WS_VAT); bf16* const QB = (bf16*)(ws + WS_QB);
    bf16* const KB = (bf16*)(ws + WS_KB); bf16* const VBT = (bf16*)(ws + WS_VBT); bf16* const GATE = (bf16*)(ws + WS_GATE);
    bf16* const OA = (bf16*)(ws + WS_OA); bf16* const OB = (bf16*)(ws + WS_OB); bf16* const X1B = (bf16*)(ws + WS_X1B); bf16* const U = (bf16*)(ws + WS_U);
    float* const SS = (float*)(ws + WS_SS);

#ifdef MK_TWOPASS
    for (int pass_ = 0; pass_ < 2; ++pass_) { if (pass_) GRID_BAR();
#endif
    constexpr int P0_I_IN = (D / 64) * (NIN / 32), P0_NITEMS = P0_I_IN + 2 * (AW / 64) * (D / 32) + (D / 64) * (D / 32) + 2 * (D / 64) * (FF / 32) + (FF / 64) * (D / 32);
    if (IN(0)) {
#ifdef MK_STAMP_A
        const unsigned p0_t0 = (unsigned)__builtin_amdgcn_s_memrealtime();
#endif
        p0_prologue(F, args, 0, P0_I_IN, F.vcu * NWAVES + F.wave, F.G * NWAVES, true);
#ifdef MK_STAMP_A
        { const unsigned p0_t1 = (unsigned)__builtin_amdgcn_s_memrealtime(); if (MK_STAMP_A == 30) enc_a = p0_t0 - (unsigned)ts0; if (MK_STAMP_A == 31) enc_a = p0_t1 - p0_t0; }
#endif
        if (BOTH(0)) { GRID_BAR();
            if (MK_GROUP_BAR && (F.G & 7) == 0 && F.G <= NWAVES * 64) { int ok = 1;
                if (F.tid < F.G) { const unsigned a_ = __hip_atomic_load(F.ctl + CW_XCC + F.tid, RLX_AGENT), r_ = __hip_atomic_load(F.ctl + CW_XCC + (F.tid & 7), RLX_AGENT); ok = (a_ != 0u && a_ == r_) ? 1 : 0; }
                grp_local = __syncthreads_and(ok) != 0; } }
        STAMP(); }

    if (IN(1)) {
        pg8::Gemm g{XN, WIN, M, NIN, D}; pg8::StaticOrder S; S.init(M, NIN, F.G, (int)blockIdx.x, MK_WGM_P1);
        LAS float* gl = (LAS float*)(F.lds + EPI_TAB_OFF);
        if (F.tid < 256) { const int w = F.tid >> 6, i = F.tid & 63; gl[F.tid] = (w == 0 ? args.in[3] : w == 1 ? args.in[4] : w == 2 ? args.in[6] : args.in[7])[i]; }
        __syncthreads();
        pg8::EpiInProj E{QA, KA, VAT, QB, KB, VBT, GATE, gl, gl + 64, gl + 128, gl + 192};
        pg8::gemm_phase<pg8::EpiInProj, pg8::StaticOrder, PG8_ALIGN, PG8_SP2>(F.lds + RING_OFF, g, S, E);
#if defined(MK_STAMP_A) && MK_STAMP_A >= 40
        if (F.tid == 0) { if (MK_STAMP_A == 41) enc_a = ((LAS unsigned*)(F.lds + LDSCTL_OFF + 128))[0]; if (MK_STAMP_A == 61) enc_a = ((LAS unsigned*)(F.lds + LDSCTL_OFF + 128))[1]; ((LAS unsigned*)(F.lds + LDSCTL_OFF + 128))[0] = 0u; }
#endif
        {
            const int heavy = (M / 256) * (NIN / 256) - 4 * F.G;
            const int light = F.G - heavy, me = (int)blockIdx.x - heavy;
            if (me >= 0 && me < 8) {
                att::Tensors AT0{nullptr, nullptr, nullptr, nullptr, nullptr, nullptr, nullptr, nullptr, args.in[5], args.in[3], args.in[4], args.in[6], args.in[7], args.in[8], args.in[9]};
                att::build_tables(F.lds + RING_OFF, (float*)(ws + WS_TABS), AT0, me, F.tid, F.wave, F.lane); }
            if (heavy > 0 && light > 0) p0_prologue(F, args, P0_I_IN, P0_NITEMS, me >= 0 ? me * NWAVES + F.wave : -1, light * NWAVES, false);
            else p0_prologue(F, args, P0_I_IN, P0_NITEMS, F.vcu * NWAVES + F.wave, F.G * NWAVES, false);
        }
        if (BOTH(1)) GRID_BAR();
        STAMP();
    }

    if (IN(2)) {
        att::Tensors AT{QA, KA, VAT, QB, KB, VBT, OA, OB, args.in[5], args.in[3], args.in[4], args.in[6], args.in[7], args.in[8], args.in[9]};
#ifdef MK_STAMP_A
        const unsigned p2_t0 = (unsigned)__builtin_amdgcn_s_memrealtime();
#endif
        att::attn_phase(F.lds + RING_OFF, AT, (const float*)(ws + WS_TABS), F.vcu, F.tid, F.wave, F.lane);
#ifdef MK_STAMP_A
        if (F.tid == 0) { const unsigned s0 = ((LAS unsigned*)(F.lds + LDSCTL_OFF + 64))[0], s1 = ((LAS unsigned*)(F.lds + LDSCTL_OFF + 64))[1], e_ = (unsigned)__builtin_amdgcn_s_memrealtime();
            if (MK_STAMP_A == 20) enc_a = s0 - p2_t0; if (MK_STAMP_A == 21) enc_a = s1 - s0; if (MK_STAMP_A == 22) enc_a = e_ - s1; }
#endif
        if (BOTH(2)) GROUP_BAR();
        STAMP();
    }

    if (IN(3)) {
        pg8::Gemm g{OA, WB, M, D, D}; pg8::StaticOrder S; S.init(M, D, F.G, (int)blockIdx.x);
        pg8::EpiBranch E{Y, GATE};
        pg8::gemm_phase<pg8::EpiBranch, pg8::StaticOrder, PG8_ALIGN, PG8_SP2>(F.lds + RING_OFF, g, S, E);
#if defined(MK_STAMP_A) && MK_STAMP_A >= 40
        if (F.tid == 0) { if (MK_STAMP_A == 43) enc_a = ((LAS unsigned*)(F.lds + LDSCTL_OFF + 128))[0]; if (MK_STAMP_A == 63) enc_a = ((LAS unsigned*)(F.lds + LDSCTL_OFF + 128))[1]; ((LAS unsigned*)(F.lds + LDSCTL_OFF + 128))[0] = 0u; }
#endif
        if (BOTH(3)) GROUP_BAR();
        STAMP();
    }

    if (IN(4)) {
        pg8::Gemm g{Y, WO, M, D, D}; pg8::StaticOrder S; S.init(M, D, F.G, (int)blockIdx.x);
        pg8::EpiOut E{args.in[0], MK_BF16_RESID ? nullptr : args.out, X1B, args.in[13], SS, MK_HOOK4(F.vcu)};
        pg8::gemm_phase<pg8::EpiOut, pg8::StaticOrder, false, PG8_SP2>(F.lds + RING_OFF, g, S, E);
#if defined(MK_STAMP_A) && MK_STAMP_A >= 40
        if (F.tid == 0) { if (MK_STAMP_A == 44) enc_a = ((LAS unsigned*)(F.lds + LDSCTL_OFF + 128))[0]; if (MK_STAMP_A == 64) enc_a = ((LAS unsigned*)(F.lds + LDSCTL_OFF + 128))[1]; ((LAS unsigned*)(F.lds + LDSCTL_OFF + 128))[0] = 0u; }
#endif
        if (BOTH(4)) GRID_BAR();
        STAMP();
#ifdef MK_EXTRA_BARS
        for (int xb_ = 0; xb_ < MK_EXTRA_BARS; ++xb_) GRID_BAR();
#endif
    }

    if (IN(5)) {
        pg8::Gemm g{X1B, WGU, M, 2 * FF, D}; pg8::StaticOrder S; S.init(M, 2 * FF, F.G, (int)blockIdx.x, MK_WGM_P5);
        LAS float* rl = (LAS float*)(F.lds + EPI_TAB_OFF);
        { const int rbase = 2048 * ((int)blockIdx.x & 7);
          for (int i = F.tid; i < 2048; i += NWAVES * 64) { const f32x4 q4 = *(const f32x4*)(SS + (size_t)(rbase + i) * 4); rl[i] = __builtin_amdgcn_rsqf(((q4[0] + q4[1]) + (q4[2] + q4[3])) * (1.0f / 1024.0f) + 1e-6f); } }
        __syncthreads();
        pg8::EpiGateUp E{rl, U, FF};
        pg8::gemm_phase<pg8::EpiGateUp, pg8::StaticOrder, PG8_ALIGN, PG8_SP2>(F.lds + RING_OFF, g, S, E);
#if defined(MK_STAMP_A) && MK_STAMP_A >= 40
        if (F.tid == 0) { if (MK_STAMP_A == 45) enc_a = ((LAS unsigned*)(F.lds + LDSCTL_OFF + 128))[0]; if (MK_STAMP_A == 65) enc_a = ((LAS unsigned*)(F.lds + LDSCTL_OFF + 128))[1]; ((LAS unsigned*)(F.lds + LDSCTL_OFF + 128))[0] = 0u; }
#endif
        if (BOTH(5)) GROUP_BAR();
        STAMP();
    }

    if (IN(6)) {
        pg8::Gemm g{U, WD, M, D, FF}; pg8::StaticOrder S; S.init(M, D, F.G, (int)blockIdx.x);
        pg8::EpiDown E{args.out, MK_HOOK6(F.vcu), MK_BF16_RESID ? X1B : nullptr};
        pg8::gemm_phase<pg8::EpiDown, pg8::StaticOrder, PG8_ALIGN, PG8_SP2>(F.lds + RING_OFF, g, S, E);
#if defined(MK_STAMP_A) && MK_STAMP_A >= 40
        if (F.tid == 0) { if (MK_STAMP_A == 46) enc_a = ((LAS unsigned*)(F.lds + LDSCTL_OFF + 128))[0]; if (MK_STAMP_A == 66) enc_a = ((LAS unsigned*)(F.lds + LDSCTL_OFF + 128))[1]; ((LAS unsigned*)(F.lds + LDSCTL_OFF + 128))[0] = 0u; }
#endif
        STAMP();
    }
#ifdef MK_TWOPASS
    }
#endif
#ifdef MK_STAMP_A
    if (MK_STAMP_A == 40) enc_a = ((LAS unsigned*)(F.lds + LDSCTL_OFF + 128))[0];
    if (MK_STAMP_A == 50 && blockIdx.x == 0 && F.tid == 0) {
        unsigned mism = 0; for (int b = 0; b < 256; ++b) mism += (__hip_atomic_load(F.ctl + CW_XCC + b, RLX_AGENT) != __hip_atomic_load(F.ctl + CW_XCC + (b & 7), RLX_AGENT)) ? 1u : 0u;
        unsigned distinct = 0; for (int b = 0; b < 8; ++b) { bool isnew = true; for (int c = 0; c < b; ++c) isnew = isnew && (__hip_atomic_load(F.ctl + CW_XCC + b, RLX_AGENT) != __hip_atomic_load(F.ctl + CW_XCC + c, RLX_AGENT)); distinct += isnew ? 1u : 0u; }
        enc_a = (mism * 100u + distinct) * 100u; }
    if (blockIdx.x == 0 && F.tid == 0) {
        const unsigned long long target = 100000ull + 3ull * (unsigned long long)enc_a + 0ull * enc_b;
        while (__builtin_amdgcn_s_memrealtime() - ts0 < target) __builtin_amdgcn_s_sleep(2);
    }
#endif
#undef IN
#undef BOTH
#undef GRID_BAR
}

extern "C" void kernel_launch(void* const* d_in, const int* in_sizes, int n_in, void* d_out, int out_size, void* d_ws, size_t ws_size, hipStream_t stream) {
    static int grid = 0;
    if (grid == 0) {
        if (n_in != 17 || in_sizes[0] != M * D || out_size != M * D || ws_size < WS_END) { fprintf(stderr, "kernel_launch: unexpected shapes (n_in %d, in0 %d, out %d, ws %zu); nothing launched\n", n_in, n_in > 0 ? in_sizes[0] : -1, out_size, ws_size); grid = -1; return; }
        int dev = 0, cus = 0, per_cu = 0;
        if (hipGetDevice(&dev) != hipSuccess || hipDeviceGetAttribute(&cus, hipDeviceAttributeMultiprocessorCount, dev) != hipSuccess) { grid = -1; return; }
        if (hipFuncSetAttribute((const void*)skel_fwd, hipFuncAttributeMaxDynamicSharedMemorySize, LDS_BYTES) != hipSuccess) { fprintf(stderr, "kernel_launch: hipFuncSetAttribute failed\n"); grid = -1; return; }
        if (hipOccupancyMaxActiveBlocksPerMultiprocessor(&per_cu, (const void*)skel_fwd, NWAVES * 64, LDS_BYTES) != hipSuccess || per_cu < 1) { fprintf(stderr, "kernel_launch: occupancy query says %d workgroups per CU\n", per_cu); per_cu = 1; }
        (void)hipGetLastError();
        grid = cus * per_cu < 256 ? cus * per_cu : 256;
        if (grid != 256) fprintf(stderr, "kernel_launch: grid %d (expected 256)\n", grid);
    }
    if (grid < 0) return;
    (void)hipMemsetAsync((char*)d_ws + WS_CTL, 0, CTL_ZERO_BYTES, stream);
    Args a{};
    for (int i = 0; i < 17; ++i) a.in[i] = (const float*)d_in[i];
    a.out = (float*)d_out; a.ws = (unsigned char*)d_ws;
#ifdef MK_DEBUG_MASK
    using namespace nv;
    unsigned char* ws = (unsigned char*)d_ws; float* out = (float*)d_out;
    Bufs b;
    b.QA = (nv::bf16*)(ws + WS_QA); b.KA = (nv::bf16*)(ws + WS_KA); b.VAT = (nv::bf16*)(ws + WS_VAT); b.QB = (nv::bf16*)(ws + WS_QB); b.KB = (nv::bf16*)(ws + WS_KB); b.VBT = (nv::bf16*)(ws + WS_VBT);
    b.GATE = (nv::bf16*)(ws + WS_GATE); b.OA = (nv::bf16*)(ws + WS_OA); b.OB = (nv::bf16*)(ws + WS_OB); b.Y = (nv::bf16*)(ws + WS_Y); b.X1B = (nv::bf16*)(ws + WS_X1B); b.U = (nv::bf16*)(ws + WS_U);
    b.RS1 = (float*)(ws + WS_RS1); b.SS = (float*)(ws + WS_SS);
    for (int k = 0; k < N_PHASES; ++k) {
        if ((MK_DEBUG_MASK >> k) & 1) { a.ph_lo = k; a.ph_hi = k + 1; hipLaunchKernelGGL(skel_fwd, dim3(grid), dim3(NWAVES * 64), LDS_BYTES, stream, a);
#ifdef DBG_TWICE
            if (k == DBG_TWICE) hipLaunchKernelGGL(skel_fwd, dim3(grid), dim3(NWAVES * 64), LDS_BYTES, stream, a);
#endif
            continue; }
        switch (k) {
        case 1: k_rowscale<<<M_ / 4, 256, 0, stream>>>(a.in[0], b.RS1);
                k_inproj<<<dim3(NIN_ / 64, M_ / 64), 256, 0, stream>>>(a.in[0], a.in[1], b.RS1, a.in[2], a.in[3], a.in[4], a.in[6], a.in[7], b);
                k_gatefix<<<M_ * 1024 / 256, 256, 0, stream>>>(b); break;
        case 2: k_natten<<<M_ * 8 / 256, 256, 0, stream>>>(a.in[5], b); k_swa<<<M_ * 8 / 256, 256, 0, stream>>>(a.in[8], a.in[9], b); break;
        case 3: k_branch<<<dim3(D_ / 64, M_ / 64), 256, 0, stream>>>(a.in[10], a.in[11], b); break;
        case 4: k_outproj<<<dim3(D_ / 64, M_ / 64), 256, 0, stream>>>(a.in[0], a.in[12], a.in[13], out, b); k_rowss<<<M_ / 4, 256, 0, stream>>>(out, b.SS); break;
        case 5: k_gateup<<<dim3(FF_ / 64, M_ / 64), 256, 0, stream>>>(out, a.in[13], a.in[14], a.in[15], b); break;
        case 6: k_down<<<dim3(D_ / 64, M_ / 64), 256, 0, stream>>>(a.in[16], out, b); break;
        default: break;
        }
    }
#else
    if (MK_REPEAT >= 0) {
        a.ph_lo = 0; a.ph_hi = MK_REPEAT + 1; hipLaunchKernelGGL(skel_fwd, dim3(grid), dim3(NWAVES * 64), LDS_BYTES, stream, a);
        (void)hipMemsetAsync((char*)d_ws + WS_CTL, 0, CTL_ZERO_BYTES, stream);
        a.ph_lo = MK_REPEAT; a.ph_hi = N_PHASES; hipLaunchKernelGGL(skel_fwd, dim3(grid), dim3(NWAVES * 64), LDS_BYTES, stream, a);
        return;
    }
    a.ph_lo = 0; a.ph_hi = N_PHASES;
    hipLaunchKernelGGL(skel_fwd, dim3(grid), dim3(NWAVES * 64), LDS_BYTES, stream, a);
#ifdef MK_TWICE
    (void)hipMemsetAsync((char*)d_ws + WS_CTL, 0, CTL_ZERO_BYTES, stream);
    hipLaunchKernelGGL(skel_fwd, dim3(grid), dim3(NWAVES * 64), LDS_BYTES, stream, a);
#endif
#endif
}
```

```cpp
#include <hip/hip_runtime.h>
#include <cstdio>
#include <cstdint>
#ifdef MK_DEBUG_MASK
#include <hip/hip_runtime.h>
#include <cstdint>
#include <cstddef>
namespace nv {
typedef unsigned short bf16;
__device__ __forceinline__ float bf2f(bf16 v) { return __uint_as_float(((unsigned)v) << 16); }
__device__ __forceinline__ bf16 f2bf(float f) { unsigned u = __float_as_uint(f); return (bf16)((u + 0x7fffu + ((u >> 16) & 1u)) >> 16); }

constexpr float QK_C2N = 0.125f * 1.4426950408889634f, LOG2EN = 1.4426950408889634f;
__host__ __device__ __forceinline__ size_t kblk(int nh, int b, int t, int h, int d) { return ((((size_t)(b * 1024 + (t >> 3)) * nh + h) * 8 + (d >> 3)) * 8 + (t & 7)) * 8 + (d & 7); }
__host__ __device__ __forceinline__ size_t vblk(int nh, int b, int t, int h, int d) { return (((size_t)(b * 1024 + (t >> 3)) * nh + h) * 64 + d) * 8 + (t & 7); }
constexpr int B_ = 2, T_ = 8192, D_ = 1024, M_ = B_ * T_, FF_ = 2816, NIN_ = 4352;

__global__ void k_rowscale(const float* __restrict__ x, float* __restrict__ rs) {
    const int gw = (blockIdx.x * blockDim.x + threadIdx.x) >> 6, lane = threadIdx.x & 63;
    if (gw >= M_) return;
    const float* r = x + (size_t)gw * D_;
    float s = 0.f;
    for (int i = lane; i < D_; i += 64) { const float v = r[i]; s += v * v; }
    for (int o = 1; o < 64; o <<= 1) s += __shfl_xor(s, o);
    if (lane == 0) rs[gw] = rsqrtf(s * (1.0f / D_) + 1e-6f);
}
__global__ void k_rowss(const float* __restrict__ x, float* __restrict__ ss) {
    const int gw = (blockIdx.x * blockDim.x + threadIdx.x) >> 6, lane = threadIdx.x & 63;
    if (gw >= M_) return;
    const float* r = x + (size_t)gw * D_;
    float s = 0.f;
    for (int i = lane; i < D_; i += 64) { const float v = r[i]; s += v * v; }
    for (int o = 1; o < 64; o <<= 1) s += __shfl_xor(s, o);
    if (lane < 4) ss[(size_t)gw * 4 + lane] = lane == 0 ? s : 0.f;
}

template <class LA>
__device__ __forceinline__ void tile_gemm(float (&acc)[4][4], LA la, const float* __restrict__ Bm, int ldb, int K, int m0, int n0, float* As, float* Bs) {
    const int tid = threadIdx.x, tx = tid & 15, ty = tid >> 4;
#pragma unroll
    for (int i = 0; i < 4; ++i)
#pragma unroll
        for (int j = 0; j < 4; ++j) acc[i][j] = 0.f;
    for (int k0 = 0; k0 < K; k0 += 16) {
#pragma unroll
        for (int i = 0; i < 4; ++i) { const int e = tid + i * 256, r = e >> 4, kk = e & 15; As[kk * 65 + r] = la(m0 + r, k0 + kk); }
#pragma unroll
        for (int i = 0; i < 4; ++i) { const int e = tid + i * 256, kk = e >> 6, c = e & 63; Bs[kk * 64 + c] = Bm[(size_t)(k0 + kk) * ldb + n0 + c]; }
        __syncthreads();
#pragma unroll
        for (int kk = 0; kk < 16; ++kk) {
            float a[4], b[4];
#pragma unroll
            for (int i = 0; i < 4; ++i) a[i] = As[kk * 65 + ty * 4 + i];
#pragma unroll
            for (int j = 0; j < 4; ++j) b[j] = Bs[kk * 64 + tx * 4 + j];
#pragma unroll
            for (int i = 0; i < 4; ++i)
#pragma unroll
                for (int j = 0; j < 4; ++j) acc[i][j] = fmaf(a[i], b[j], acc[i][j]);
        }
        __syncthreads();
    }
}

struct Bufs {
    bf16 *QA, *KA, *VAT, *QB, *KB, *VBT, *GATE, *OA, *OB, *Y, *X1B, *U;
    float *RS1, *SS;
};

__global__ void __launch_bounds__(256) k_inproj(const float* __restrict__ x, const float* __restrict__ g1, const float* __restrict__ rs1, const float* __restrict__ w_in,
                                                const float* __restrict__ qna, const float* __restrict__ kna, const float* __restrict__ qnb, const float* __restrict__ knb, Bufs b) {
    __shared__ float As[16 * 65], Bs[16 * 64], red[64 * 17];
    const int n0 = blockIdx.x * 64, m0 = blockIdx.y * 64, tid = threadIdx.x, tx = tid & 15, ty = tid >> 4;
    float acc[4][4];
    tile_gemm(acc, [&](int m, int k) { return x[(size_t)m * D_ + k] * g1[k]; }, w_in, NIN_, D_, m0, n0, As, Bs);
#pragma unroll
    for (int i = 0; i < 4; ++i) { const float r = rs1[m0 + ty * 4 + i];
#pragma unroll
        for (int j = 0; j < 4; ++j) acc[i][j] *= r; }
    const float* gn = nullptr;
    if (n0 < 512) gn = qna; else if (n0 < 1024) gn = kna; else if (n0 >= 1536 && n0 < 2048) gn = qnb; else if (n0 >= 2048 && n0 < 2176) gn = knb;
    if (gn) {
#pragma unroll
        for (int i = 0; i < 4; ++i) { float s = 0.f;
#pragma unroll
            for (int j = 0; j < 4; ++j) s += acc[i][j] * acc[i][j];
            red[(ty * 4 + i) * 17 + tx] = s; }
        __syncthreads();
#pragma unroll
        for (int i = 0; i < 4; ++i) { float s = 0.f;
            for (int t = 0; t < 16; ++t) s += red[(ty * 4 + i) * 17 + t];
            const float r = rsqrtf(s * (1.0f / 64.0f) + 1e-6f);
#pragma unroll
            for (int j = 0; j < 4; ++j) acc[i][j] = acc[i][j] * r * gn[tx * 4 + j]; }
    }
#pragma unroll
    for (int i = 0; i < 4; ++i) { const int m = m0 + ty * 4 + i;
#pragma unroll
        for (int j = 0; j < 4; ++j) { const int n = n0 + tx * 4 + j; const float v = acc[i][j];
            if (n < 512) b.QA[(size_t)m * 512 + n] = f2bf(v * QK_C2N);
            else if (n < 1024) { const int c = n - 512; b.KA[kblk(8, m / T_, m % T_, c >> 6, c & 63)] = f2bf(v); }
            else if (n < 1536) { const int c = n - 1024, h = c >> 6, d = c & 63, bb = m / T_, t = m % T_; b.VAT[vblk(8, bb, t, h, d)] = f2bf(v); }
            else if (n < 2048) b.QB[(size_t)m * 512 + (n - 1536)] = f2bf(v * QK_C2N);
            else if (n < 2176) { const int c = n - 2048; b.KB[kblk(2, m / T_, m % T_, c >> 6, c & 63)] = f2bf(v); }
            else if (n < 2304) { const int c = n - 2176, h = c >> 6, d = c & 63, bb = m / T_, t = m % T_; b.VBT[vblk(2, bb, t, h, d)] = f2bf(v); }
            else b.GATE[(size_t)m * 2048 + (n - 2304)] = f2bf(1.0f / (1.0f + expf(-v))); } }
}

__global__ void __launch_bounds__(256) k_natten(const float* __restrict__ rpb, Bufs b) {
    const int gid = blockIdx.x * 256 + threadIdx.x; if (gid >= M_ * 8) return;
    const int h = gid & 7, m = gid >> 3, bb = m / T_, t = m % T_, r = t >> 6, qc = t & 63;
    int rs = r - 4; rs = rs < 0 ? 0 : (rs > 120 ? 120 : rs);
    int ws = qc - 8; ws = ws < 0 ? 0 : (ws > 48 ? 48 : ws);
    float q[64], o[64];
#pragma unroll
    for (int d = 0; d < 64; ++d) { q[d] = bf2f(b.QA[(size_t)m * 512 + h * 64 + d]); o[d] = 0.f; }
    float mx = -3.0e38f, l = 0.f;
    for (int kr = 0; kr < 8; ++kr)
        for (int kc = 0; kc < 16; ++kc) {
            const int krow = rs + kr, kcol = ws + kc, tk = krow * 64 + kcol; const size_t mk = (size_t)bb * T_ + tk;
            float s = 0.f;
#pragma unroll
            for (int d = 0; d < 64; ++d) s = fmaf(q[d], bf2f(b.KA[kblk(8, bb, tk, h, d)]), s);
            const int dr = krow - r + 7, dc = kcol - qc + 15;
            s = s + rpb[(dr * 31 + dc) * 8 + h] * LOG2EN;
            const float mn = fmaxf(mx, s), f = exp2f(mx - mn), p = exp2f(s - mn);
            l = l * f + p; mx = mn;
#pragma unroll
            for (int d = 0; d < 64; ++d) o[d] = o[d] * f + p * bf2f(b.VAT[vblk(8, bb, tk, h, d)]);
        }
    const float il = 1.0f / l;
#pragma unroll
    for (int d = 0; d < 64; ++d) b.OA[(size_t)m * 1024 + h * 64 + d] = f2bf(o[d] * il);
}

__device__ __forceinline__ int t5_bucket(int rel) {
    const int n = rel < 0 ? -rel : rel;
    const int large = 8 + (n >= 12) + (n >= 16) + (n >= 23) + (n >= 32) + (n >= 46) + (n >= 64) + (n >= 91);
    return (rel > 0 ? 16 : 0) + (n < 8 ? n : large);
}
__global__ void __launch_bounds__(256) k_swa(const float* __restrict__ sink, const float* __restrict__ t5, Bufs b) {
    const int gid = blockIdx.x * 256 + threadIdx.x; if (gid >= M_ * 8) return;
    const int h = gid & 7, m = gid >> 3, bb = m / T_, t = m % T_, kvh = h >> 2;
    float q[64], o[64];
#pragma unroll
    for (int d = 0; d < 64; ++d) { q[d] = bf2f(b.QB[(size_t)m * 512 + h * 64 + d]); o[d] = 0.f; }
    float mx = sink[h] * LOG2EN, l = 1.0f;
    const int lo = t - 128 < 0 ? 0 : t - 128, hi = t + 128 > T_ - 1 ? T_ - 1 : t + 128;
    for (int tk = lo; tk <= hi; ++tk) {
        const size_t mk = (size_t)bb * T_ + tk;
        float s = 0.f;
#pragma unroll
        for (int d = 0; d < 64; ++d) s = fmaf(q[d], bf2f(b.KB[kblk(2, bb, tk, kvh, d)]), s);
        s = s + t5[t5_bucket(tk - t) * 8 + h] * LOG2EN;
        const float mn = fmaxf(mx, s), f = exp2f(mx - mn), p = exp2f(s - mn);
        l = l * f + p; mx = mn;
#pragma unroll
        for (int d = 0; d < 64; ++d) o[d] = o[d] * f + p * bf2f(b.VBT[vblk(2, bb, tk, kvh, d)]);
    }
    const float il = 1.0f / l;
#pragma unroll
    for (int d = 0; d < 64; ++d) b.OB[(size_t)m * 1024 + h * 64 + d] = f2bf(o[d] * il);
}

__global__ void __launch_bounds__(256) k_gatefix(Bufs b) {
    const size_t i = (size_t)blockIdx.x * 256 + threadIdx.x; const size_t m = i >> 10, n = i & 1023;
    const float sa = bf2f(b.GATE[m * 2048 + n]), sb = bf2f(b.GATE[m * 2048 + 1024 + n]);
    b.GATE[m * 2048 + n] = f2bf(sa / sb);
}
__global__ void __launch_bounds__(256) k_branch(const float* __restrict__ wba, const float* __restrict__ wbb, Bufs b) {
    __shared__ float As[16 * 65], Bs[16 * 64];
    const int n0 = blockIdx.x * 64, m0 = blockIdx.y * 64, tid = threadIdx.x, tx = tid & 15, ty = tid >> 4;
    float a1[4][4], a2[4][4];
    tile_gemm(a1, [&](int m, int k) { return bf2f(b.OA[(size_t)m * 1024 + k]); }, wba, D_, 512, m0, n0, As, Bs);
    tile_gemm(a2, [&](int m, int k) { return bf2f(b.OB[(size_t)m * 1024 + k]); }, wbb, D_, 512, m0, n0, As, Bs);
#pragma unroll
    for (int i = 0; i < 4; ++i) { const int m = m0 + ty * 4 + i;
#pragma unroll
        for (int j = 0; j < 4; ++j) { const int n = n0 + tx * 4 + j;
            const float ga = bf2f(b.GATE[(size_t)m * 2048 + n]), gb = bf2f(b.GATE[(size_t)m * 2048 + 1024 + n]);
            b.Y[(size_t)m * D_ + n] = f2bf(gb * (ga * a1[i][j] + a2[i][j])); } }
}
__global__ void __launch_bounds__(256) k_outproj(const float* __restrict__ x, const float* __restrict__ wout, const float* __restrict__ g2, float* __restrict__ out, Bufs b) {
    __shared__ float As[16 * 65], Bs[16 * 64];
    const int n0 = blockIdx.x * 64, m0 = blockIdx.y * 64, tid = threadIdx.x, tx = tid & 15, ty = tid >> 4;
    float a1[4][4];
    tile_gemm(a1, [&](int m, int k) { return bf2f(b.Y[(size_t)m * D_ + k]); }, wout, D_, D_, m0, n0, As, Bs);
#pragma unroll
    for (int i = 0; i < 4; ++i) { const int m = m0 + ty * 4 + i;
#pragma unroll
        for (int j = 0; j < 4; ++j) { const int n = n0 + tx * 4 + j; const float v = x[(size_t)m * D_ + n] + a1[i][j];
            out[(size_t)m * D_ + n] = v; b.X1B[(size_t)m * D_ + n] = f2bf(v * g2[n]); } }
}
__global__ void __launch_bounds__(256) k_gateup(const float* __restrict__ x1, const float* __restrict__ g2, const float* __restrict__ wg, const float* __restrict__ wu, Bufs b) {
    __shared__ float As[16 * 65], Bs[16 * 64];
    const int n0 = blockIdx.x * 64, m0 = blockIdx.y * 64, tid = threadIdx.x, tx = tid & 15, ty = tid >> 4;
    float a1[4][4], a2[4][4];
    auto la = [&](int m, int k) { return x1[(size_t)m * D_ + k] * g2[k]; };
    tile_gemm(a1, la, wg, FF_, D_, m0, n0, As, Bs);
    tile_gemm(a2, la, wu, FF_, D_, m0, n0, As, Bs);
#pragma unroll
    for (int i = 0; i < 4; ++i) { const int m = m0 + ty * 4 + i;
        const float* s4 = b.SS + (size_t)m * 4; const float r = rsqrtf(((s4[0] + s4[1]) + (s4[2] + s4[3])) * (1.0f / D_) + 1e-6f);
#pragma unroll
        for (int j = 0; j < 4; ++j) { const int n = n0 + tx * 4 + j; const float g = a1[i][j] * r, u = a2[i][j] * r;
            b.U[(size_t)m * FF_ + n] = f2bf(g / (1.0f + expf(-g)) * u); } }
}
__global__ void __launch_bounds__(256) k_down(const float* __restrict__ wd, float* __restrict__ out, Bufs b) {
    __shared__ float As[16 * 65], Bs[16 * 64];
    const int n0 = blockIdx.x * 64, m0 = blockIdx.y * 64, tid = threadIdx.x, tx = tid & 15, ty = tid >> 4;
    float a1[4][4];
    tile_gemm(a1, [&](int m, int k) { return bf2f(b.U[(size_t)m * FF_ + k]); }, wd, D_, FF_, m0, n0, As, Bs);
#pragma unroll
    for (int i = 0; i < 4; ++i) { const int m = m0 + ty * 4 + i;
#pragma unroll
        for (int j = 0; j < 4; ++j) { const int n = n0 + tx * 4 + j; out[(size_t)m * D_ + n] += a1[i][j]; } }
}
}
#endif
#if defined(MK_STAMP_A) && MK_STAMP_A >= 40
#define PG8_KSTAMP_BEGIN() const unsigned kst0_ = (unsigned)__builtin_amdgcn_s_memrealtime()
#define PG8_KSTAMP_END() do { if (tid == 0) ((PG8_LAS unsigned*)(lds + (155648 - 1024) + 128))[0] += (unsigned)__builtin_amdgcn_s_memrealtime() - kst0_; } while (0)
#if MK_STAMP_A >= 60
#ifndef MK_TRIP_T
#define MK_TRIP_T 2
#endif
#define PG8_KSTAMP_TRIP() do { if (tid == 0 && ui == 0 && t == MK_TRIP_T) ((PG8_LAS unsigned*)(lds + (155648 - 1024) + 128))[1] = (unsigned)__builtin_amdgcn_s_memrealtime() - kst0_; } while (0)
#else
#define PG8_KSTAMP_TRIP() do {} while (0)
#endif
#endif
namespace pg8 {
#define PG8_LAS __attribute__((address_space(3)))
typedef unsigned short bf16_t;
typedef short bf16x8 __attribute__((ext_vector_type(8)));
typedef float f32x4 __attribute__((ext_vector_type(4)));
typedef unsigned u32x4 __attribute__((ext_vector_type(4)));
constexpr int BM = 256, BK = 64, HALF = 128, HTB = HALF * BK * 2  , STAGE_BYTES = 8 * HTB, NXCD = 8, WGM = 8;

__host__ __device__ __forceinline__ int lds_byte(int r, int c) { const int st = (r >> 4) * 2 + (c >> 5), rr = r & 15, cc = c & 31, ob = rr * 64 + cc * 2; return st * 1024 + (ob ^ (((ob >> 9) & 1) << 5)); }
__host__ __device__ __forceinline__ void stage_rc(int b, int& R, int& C) { const int st = b / 1024, sb = b % 1024, swz = sb ^ (((sb >> 9) & 1) << 5); R = (st >> 1) * 16 + swz / 64; C = (st & 1) * 32 + (swz % 64) / 2; }
__host__ __device__ __forceinline__ int perm32(int rho) { const int n = rho >> 4, i = rho & 15; return 8 * (i >> 2) + 4 * n + (i & 3); }

struct Unit { int pm, pn; };
struct Gemm { const bf16_t* A; const bf16_t* Bt; int M, N, K; };

struct StaticOrder {
    int nM, nN, nwg, G, c, wgm;
    __host__ __device__ void init(int M, int N, int G_, int c_, int wgm_ = WGM) { nM = M / BM; nN = N / BM; nwg = nM * nN; G = G_; c = c_; wgm = wgm_; }
    __host__ __device__ bool next(int i, Unit& u) const {
        const long L = (long)i * G + c; if (L >= nwg) return false;
        int wgid = (int)L; { const int q = nwg / NXCD, r = nwg % NXCD, xcd = wgid % NXCD, off = wgid / NXCD; wgid = (xcd < r ? xcd * (q + 1) : r * (q + 1) + (xcd - r) * q) + off; }
        const int nig = wgm * nN, gid = wgid / nig, fm = gid * wgm, gsz = (nM - fm) < wgm ? (nM - fm) : wgm;
        u.pm = fm + ((wgid % nig) % gsz); u.pn = (wgid % nig) / gsz; return true;
    }
    __device__ __forceinline__ void a_ready(const Unit&) const {}
    __device__ __forceinline__ void done(const Unit&) const {}
};
__device__ __forceinline__ unsigned cvt_pk_bf16(float lo, float hi) { unsigned r; asm volatile("v_cvt_pk_bf16_f32 %0, %1, %2" : "=v"(r) : "v"(lo), "v"(hi)); return r; }
typedef float f32x2 __attribute__((ext_vector_type(2)));
#ifndef EPI_NT
#define EPI_NT 0
#endif
#if EPI_NT
#define EPI_ST(p, v) __builtin_nontemporal_store((v), (p))
#else
#define EPI_ST(p, v) (*(p) = (v))
#endif
#ifndef EPI_INIT_ACC
#define EPI_INIT_ACC 1
#endif
#ifndef EPI_NT_LD
#define EPI_NT_LD 1
#endif
#if EPI_NT_LD
#define EPI_LD(p) __builtin_nontemporal_load(p)
#else
#define EPI_LD(p) (*(p))
#endif
#ifndef EPI_WT
#define EPI_WT 1
#endif
#ifndef EPI_WT_QKV
#define EPI_WT_QKV 0
#endif
#ifndef EPI_WT_Y
#define EPI_WT_Y 0
#endif
typedef int epi_i32x4 __attribute__((ext_vector_type(4)));
__device__ __forceinline__ void store_wt16(void* p, u32x4 v) {
#if EPI_WT
    *(u32x4*)p = v;
#else
    *(u32x4*)p = v;
#endif
}
__device__ __forceinline__ void store_wt16(const __amdgpu_buffer_rsrc_t rsrc, unsigned byte_off, u32x4 v) {
    __builtin_amdgcn_raw_buffer_store_b128(__builtin_bit_cast(epi_i32x4, v), rsrc, (int)byte_off, 0, 16  );
}
typedef int epi_i32x2 __attribute__((ext_vector_type(2)));
__device__ __forceinline__ void store_wt8(const __amdgpu_buffer_rsrc_t rsrc, unsigned byte_off, unsigned lo, unsigned hi) {
    __builtin_amdgcn_raw_buffer_store_b64((epi_i32x2){(int)lo, (int)hi}, rsrc, (int)byte_off, 0, 16);
}
#define EPI_RSRC(p) __builtin_amdgcn_make_buffer_rsrc((void*)(p), 0, 0x7fffffff, 0x00020000)
constexpr float QK_C2 = 0.125f * 1.4426950408889634f;
constexpr float LOG2E = 1.4426950408889634f;
constexpr int EP_T = 8192;
typedef float epi_f32x2 __attribute__((ext_vector_type(2)));
typedef __bf16 epi_bf16x2 __attribute__((ext_vector_type(2)));
__device__ __forceinline__ unsigned cvt_pk_safe(float lo, float hi) { epi_f32x2 v = {lo, hi}; epi_bf16x2 b = __builtin_convertvector(v, epi_bf16x2); return __builtin_bit_cast(unsigned, b); }
__device__ __forceinline__ float fast_sigmoid(float v) { return __builtin_amdgcn_rcpf(1.0f + __builtin_amdgcn_exp2f(-LOG2E * v)); }
__device__ __forceinline__ float bf_lo(unsigned w) { return __uint_as_float(w << 16); }
__device__ __forceinline__ float bf_hi(unsigned w) { return __uint_as_float(w & 0xffff0000u); }

__device__ __forceinline__ size_t gate_blk(int pm, int q, int half, int ai, int m, int wr, int wc) { return (size_t)(((((((pm * 8 + q) * 2 + half) * 2 + ai) * 4 + m) * 2 + wr) * 4 + wc)) * 512; }
struct EpiInProj {
    static constexpr bool INIT_ACC = false;
    static constexpr bool PERM = true, AFTER_DRAIN = false; static constexpr int MID_T = -1;
    bf16_t *QA, *KA, *VAT, *QB, *KB, *VBT, *GATE; const PG8_LAS float *qna, *kna, *qnb, *knb; PG8_LAS unsigned char* vscr;
    template <int MODE, int NH = 0> __device__ __forceinline__ void rowmajor(const f32x4 (&acc)[2][2][4][2], bf16_t* dst, int ld, int row0, int fq, const PG8_LAS float* gain, float scale, int hb = 0) const {
        const __amdgpu_buffer_rsrc_t drs = EPI_RSRC(dst);
        f32x4 g[2][2];
        if (MODE == 1) {
#pragma unroll
            for (int bj = 0; bj < 2; ++bj)
#pragma unroll
                for (int n = 0; n < 2; ++n) g[bj][n] = *(const PG8_LAS f32x4*)(gain + 32 * bj + 8 * fq + 4 * n) * scale;
        }
#pragma unroll
        for (int ai = 0; ai < 2; ++ai)
#pragma unroll
            for (int m = 0; m < 4; ++m) {
                const int t_ = row0 + ai * HALF + m * 16;
                bf16_t* rowp = NH ? dst + ((size_t)((t_ >> 3) * NH + hb) * 64 + fq * 8 + (t_ & 7)) * 8 : dst + (size_t)t_ * ld + 8 * fq;
                f32x4 v[2][2];
#pragma unroll
                for (int bj = 0; bj < 2; ++bj)
#pragma unroll
                    for (int n = 0; n < 2; ++n) v[bj][n] = acc[ai][bj][m][n];
                if (MODE == 1) {
                    float ss = 0.f;
#pragma unroll
                    for (int bj = 0; bj < 2; ++bj)
#pragma unroll
                        for (int n = 0; n < 2; ++n) { const f32x4 x = v[bj][n]; ss += (x[0] * x[0] + x[1] * x[1]) + (x[2] * x[2] + x[3] * x[3]); }
                    ss += __shfl_xor(ss, 16); ss += __shfl_xor(ss, 32);
                    const float r = __builtin_amdgcn_rsqf(ss * (1.0f / 64.0f) + 1e-6f);
#pragma unroll
                    for (int bj = 0; bj < 2; ++bj)
#pragma unroll
                        for (int n = 0; n < 2; ++n) v[bj][n] = v[bj][n] * r * g[bj][n];
                } else if (MODE == 2) {
#pragma unroll
                    for (int bj = 0; bj < 2; ++bj)
#pragma unroll
                        for (int n = 0; n < 2; ++n)
#pragma unroll
                            for (int e = 0; e < 4; ++e) v[bj][n][e] = fast_sigmoid(v[bj][n][e]);
                }
#pragma unroll
                for (int bj = 0; bj < 2; ++bj) { u32x4 w; w.x = cvt_pk_safe(v[bj][0][0], v[bj][0][1]); w.y = cvt_pk_safe(v[bj][0][2], v[bj][0][3]); w.z = cvt_pk_safe(v[bj][1][0], v[bj][1][1]); w.w = cvt_pk_safe(v[bj][1][2], v[bj][1][3]);
                    if (EPI_WT_QKV) store_wt16(drs, (unsigned)((size_t)((rowp + (NH ? 256 : 32) * bj) - dst) * 2), w); else EPI_ST((u32x4*)(rowp + (NH ? 256 : 32) * bj), w); }
            }
    }
    template <int NH> __device__ __forceinline__ void vblocked(const f32x4 (&acc)[2][2][4][2], bf16_t* dst, int t0w  , int fr, int fq, int hb) const {
        PG8_LAS unsigned char* scr = vscr;
        const int lane = fr + 16 * fq;
#pragma unroll
        for (int ai = 0; ai < 2; ++ai)
#pragma unroll
            for (int m = 0; m < 4; ++m) {
#pragma unroll
                for (int bj = 0; bj < 2; ++bj) { u32x4 w; w.x = cvt_pk_safe(acc[ai][bj][m][0][0], acc[ai][bj][m][0][1]); w.y = cvt_pk_safe(acc[ai][bj][m][0][2], acc[ai][bj][m][0][3]);
                    w.z = cvt_pk_safe(acc[ai][bj][m][1][0], acc[ai][bj][m][1][1]); w.w = cvt_pk_safe(acc[ai][bj][m][1][2], acc[ai][bj][m][1][3]);
                    *(PG8_LAS u32x4*)(scr + fr * 144 + (32 * bj + 8 * fq) * 2) = w; }
                u32x4 o0, o1;
                { const PG8_LAS unsigned short* c = (const PG8_LAS unsigned short*)(scr + lane * 2);
#define EPI_TK(t) ((unsigned)c[(t) * 72])
                  o0.x = EPI_TK(0) | (EPI_TK(1) << 16); o0.y = EPI_TK(2) | (EPI_TK(3) << 16); o0.z = EPI_TK(4) | (EPI_TK(5) << 16); o0.w = EPI_TK(6) | (EPI_TK(7) << 16);
                  o1.x = EPI_TK(8) | (EPI_TK(9) << 16); o1.y = EPI_TK(10) | (EPI_TK(11) << 16); o1.z = EPI_TK(12) | (EPI_TK(13) << 16); o1.w = EPI_TK(14) | (EPI_TK(15) << 16);
#undef EPI_TK
                }
                const int tg = t0w + ai * HALF + m * 16;
                bf16_t* p = dst + ((size_t)((tg >> 3) * NH + hb) * 64 + lane) * 8;
                *(u32x4*)p = o0; *(u32x4*)(p + (size_t)NH * 512) = o1;
            }
    }
    __device__ __forceinline__ void operator()(const f32x4 (&acc)[2][2][4][2], const Unit& u, int wr, int wc, int fr, int fq) const {
        asm volatile("" : "+v"(fr), "+v"(fq));
        const int pn = u.pn, row0 = u.pm * BM + wr * 64 + fr;
        const int b = (u.pm * BM) / EP_T, t0 = (u.pm * BM) % EP_T + wr * 64 + fr;
        if (pn < 2) rowmajor<1>(acc, QA + pn * 256 + 64 * wc, 512, row0, fq, qna, QK_C2);
        else if (pn < 4) rowmajor<1, 8>(acc, KA, 0, t0, fq, kna, 1.0f, b * 1024 * 8 + (pn - 2) * 4 + wc);
        else if (pn < 6) vblocked<8>(acc, VAT, t0 - fr, fr, fq, b * 1024 * 8 + (pn - 4) * 4 + wc);
        else if (pn < 8) rowmajor<1>(acc, QB + (pn - 6) * 256 + 64 * wc, 512, row0, fq, qnb, QK_C2);
        else if (pn == 8) { if (wc < 2) rowmajor<1, 2>(acc, KB, 0, t0, fq, knb, 1.0f, b * 1024 * 2 + wc);
                            else vblocked<2>(acc, VBT, t0 - fr, fr, fq, b * 1024 * 2 + (wc - 2)); }
        else gates(acc, GATE, u.pm, pn - 9, wr, wc, fr + 16 * fq);
    }
    __device__ __forceinline__ void gates(const f32x4 (&acc)[2][2][4][2], bf16_t* dst  , int pm, int q, int wr, int wc, int lane) const {
        const __amdgpu_buffer_rsrc_t grs = EPI_RSRC(dst);
#pragma unroll
        for (int ai = 0; ai < 2; ++ai)
#pragma unroll
            for (int m = 0; m < 4; ++m) { bf16_t* p1 = dst + gate_blk(pm, q, 0, ai, m, wr, wc) + lane * 8; bf16_t* p2 = dst + gate_blk(pm, q, 1, ai, m, wr, wc) + lane * 8; float g1[8], g2[8];
#pragma unroll
                for (int n = 0; n < 2; ++n)
#pragma unroll
                    for (int e = 0; e < 4; ++e) { const float ea = __builtin_amdgcn_exp2f(-LOG2E * acc[ai][0][m][n][e]), eb = fminf(__builtin_amdgcn_exp2f(-LOG2E * acc[ai][1][m][n][e]), 1.0e30f);
                        g2[4 * n + e] = __builtin_amdgcn_rcpf(1.0f + eb); g1[4 * n + e] = (1.0f + eb) * __builtin_amdgcn_rcpf(1.0f + ea); }
                u32x4 w1, w2;
                w1.x = cvt_pk_safe(g1[0], g1[1]); w1.y = cvt_pk_safe(g1[2], g1[3]); w1.z = cvt_pk_safe(g1[4], g1[5]); w1.w = cvt_pk_safe(g1[6], g1[7]);
                w2.x = cvt_pk_safe(g2[0], g2[1]); w2.y = cvt_pk_safe(g2[2], g2[3]); w2.z = cvt_pk_safe(g2[4], g2[5]); w2.w = cvt_pk_safe(g2[6], g2[7]);
                if (EPI_WT_QKV) { store_wt16(grs, (unsigned)((size_t)(p1 - dst) * 2), w1); store_wt16(grs, (unsigned)((size_t)(p2 - dst) * 2), w2); } else { EPI_ST((u32x4*)p1, w1); EPI_ST((u32x4*)p2, w2); } }
    }
};

struct EpiBranch {
    static constexpr bool INIT_ACC = false;
    static constexpr bool PERM = true, AFTER_DRAIN = false; static constexpr int MID_T = 8;
    bf16_t* Y; const bf16_t* GATE;
    __device__ __forceinline__ int mid_t() const { return MID_T; }
    template <int OFF> __device__ __forceinline__ void scale(f32x4 (&acc)[2][2][4][2], const Unit& u, int wr, int wc, int fr, int fq, bool store) const {
        asm volatile("" : "+v"(fr), "+v"(fq));
        const int row0 = u.pm * BM + wr * 64 + fr, col0 = u.pn * BM + wc * 32 + 8 * fq;
        const __amdgpu_buffer_rsrc_t yrs = EPI_RSRC(Y);
        u32x4 gq[2][4][2];
#pragma unroll
        for (int ai = 0; ai < 2; ++ai)
#pragma unroll
            for (int m = 0; m < 4; ++m)
#pragma unroll
                for (int bj = 0; bj < 2; ++bj) gq[ai][m][bj] = EPI_LD((const u32x4*)(GATE + gate_blk(u.pm, 2 * u.pn + bj, OFF ? 1 : 0, ai, m, wr, wc) + (fr + 16 * fq) * 8));
        asm volatile("" : "+v"(gq[0][0][0]), "+v"(gq[0][0][1]), "+v"(gq[0][1][0]), "+v"(gq[0][1][1]), "+v"(gq[0][2][0]), "+v"(gq[0][2][1]), "+v"(gq[0][3][0]), "+v"(gq[0][3][1]),
                          "+v"(gq[1][0][0]), "+v"(gq[1][0][1]), "+v"(gq[1][1][0]), "+v"(gq[1][1][1]), "+v"(gq[1][2][0]), "+v"(gq[1][2][1]), "+v"(gq[1][3][0]), "+v"(gq[1][3][1]));
#pragma unroll
        for (int ai = 0; ai < 2; ++ai)
#pragma unroll
            for (int m = 0; m < 4; ++m) { const size_t row = (size_t)(row0 + ai * HALF + m * 16);
#pragma unroll
                for (int bj = 0; bj < 2; ++bj) {
                    const u32x4 gw = gq[ai][m][bj];
                    f32x4 v0 = acc[ai][bj][m][0], v1 = acc[ai][bj][m][1];
                    v0[0] *= bf_lo(gw.x); v0[1] *= bf_hi(gw.x); v0[2] *= bf_lo(gw.y); v0[3] *= bf_hi(gw.y); v1[0] *= bf_lo(gw.z); v1[1] *= bf_hi(gw.z); v1[2] *= bf_lo(gw.w); v1[3] *= bf_hi(gw.w);
                    if (store) { u32x4 w; w.x = cvt_pk_safe(v0[0], v0[1]); w.y = cvt_pk_safe(v0[2], v0[3]); w.z = cvt_pk_safe(v1[0], v1[1]); w.w = cvt_pk_safe(v1[2], v1[3]);
                        if (EPI_WT_Y) store_wt16(yrs, (unsigned)((row * 1024 + col0 + bj * HALF) * 2), w); else *(u32x4*)(Y + row * 1024 + col0 + bj * HALF) = w; }
                    else { acc[ai][bj][m][0] = v0; acc[ai][bj][m][1] = v1; } } }
    }
    __device__ __forceinline__ void mid(f32x4 (&acc)[2][2][4][2], const Unit& u, int wr, int wc, int fr, int fq) const { scale<0>(acc, u, wr, wc, fr, fq, false); }
    __device__ __forceinline__ void operator()(const f32x4 (&acc)[2][2][4][2], const Unit& u, int wr, int wc, int fr, int fq) const {
        scale<1024>(const_cast<f32x4 (&)[2][2][4][2]>(acc), u, wr, wc, fr, fq, true); }
};

constexpr bool RES_PERM = true; constexpr int RC_FQ = RES_PERM ? 8 : 4, RC_N = RES_PERM ? 4 : 16;
__device__ __forceinline__ void add_residual_tile(f32x4 (&acc)[2][2][4][2], const float* src, const Unit& u, int wr, int wc, int fr, int fq) {
    asm volatile("" : "+v"(fr), "+v"(fq));
    const int row0 = u.pm * BM + wr * 64 + fr, col0 = u.pn * BM + wc * 32 + RC_FQ * fq;
#pragma unroll
    for (int ai = 0; ai < 2; ++ai) {
        f32x4 t[4][2][2];
#pragma unroll
        for (int m = 0; m < 4; ++m) { const float* rowp = src + (size_t)(row0 + ai * HALF + m * 16) * 1024 + col0;
#pragma unroll
            for (int bj = 0; bj < 2; ++bj)
#pragma unroll
                for (int n = 0; n < 2; ++n) t[m][bj][n] = EPI_LD((const f32x4*)(rowp + bj * HALF + n * RC_N)); }
        asm volatile("" : "+v"(t[0][0][0]), "+v"(t[0][0][1]), "+v"(t[0][1][0]), "+v"(t[0][1][1]), "+v"(t[1][0][0]), "+v"(t[1][0][1]), "+v"(t[1][1][0]), "+v"(t[1][1][1]),
                          "+v"(t[2][0][0]), "+v"(t[2][0][1]), "+v"(t[2][1][0]), "+v"(t[2][1][1]), "+v"(t[3][0][0]), "+v"(t[3][0][1]), "+v"(t[3][1][0]), "+v"(t[3][1][1]));
#pragma unroll
        for (int m = 0; m < 4; ++m)
#pragma unroll
            for (int bj = 0; bj < 2; ++bj)
#pragma unroll
                for (int n = 0; n < 2; ++n) acc[ai][bj][m][n] = acc[ai][bj][m][n] + t[m][bj][n];
        asm volatile("" ::: "memory"); }
}

__device__ __forceinline__ void add_residual_tile_bf16(f32x4 (&acc)[2][2][4][2], const bf16_t* src, const Unit& u, int wr, int wc, int fr, int fq) {
    typedef unsigned u32x2v __attribute__((ext_vector_type(2)));
    asm volatile("" : "+v"(fr), "+v"(fq));
    const int row0 = u.pm * BM + wr * 64 + fr, col0 = u.pn * BM + wc * 32 + RC_FQ * fq;
    u32x2v t[2][4][2][2];
#pragma unroll
    for (int ai = 0; ai < 2; ++ai)
#pragma unroll
        for (int m = 0; m < 4; ++m) { const bf16_t* rowp = src + (size_t)(row0 + ai * HALF + m * 16) * 1024 + col0;
#pragma unroll
            for (int bj = 0; bj < 2; ++bj)
#pragma unroll
                for (int n = 0; n < 2; ++n) t[ai][m][bj][n] = EPI_LD((const u32x2v*)(rowp + bj * HALF + n * RC_N)); }
#pragma unroll
    for (int ai = 0; ai < 2; ++ai)
        asm volatile("" : "+v"(t[ai][0][0][0]), "+v"(t[ai][0][0][1]), "+v"(t[ai][0][1][0]), "+v"(t[ai][0][1][1]), "+v"(t[ai][1][0][0]), "+v"(t[ai][1][0][1]), "+v"(t[ai][1][1][0]), "+v"(t[ai][1][1][1]),
                          "+v"(t[ai][2][0][0]), "+v"(t[ai][2][0][1]), "+v"(t[ai][2][1][0]), "+v"(t[ai][2][1][1]), "+v"(t[ai][3][0][0]), "+v"(t[ai][3][0][1]), "+v"(t[ai][3][1][0]), "+v"(t[ai][3][1][1]));
#pragma unroll
    for (int ai = 0; ai < 2; ++ai)
#pragma unroll
        for (int m = 0; m < 4; ++m)
#pragma unroll
            for (int bj = 0; bj < 2; ++bj)
#pragma unroll
                for (int n = 0; n < 2; ++n) { const u32x2v w = t[ai][m][bj][n]; acc[ai][bj][m][n] = acc[ai][bj][m][n] + (f32x4){bf_lo(w.x), bf_hi(w.x), bf_lo(w.y), bf_hi(w.y)}; }
}

struct EpiOut {
    static constexpr bool PERM = RES_PERM, AFTER_DRAIN = true; static constexpr int MID_T = EPI_INIT_ACC ? -1 : 0; static constexpr bool INIT_ACC = EPI_INIT_ACC;
    __device__ __forceinline__ void init_acc(f32x4 (&acc)[2][2][4][2], const Unit& u, int wr, int wc, int fr, int fq) const {
        const int row0 = u.pm * BM + wr * 64 + fr, col0 = u.pn * BM + wc * 32 + RC_FQ * fq;
#pragma unroll
        for (int ai = 0; ai < 2; ++ai)
#pragma unroll
            for (int m = 0; m < 4; ++m) { const float* rowp = x + (size_t)(row0 + ai * HALF + m * 16) * 1024 + col0;
#pragma unroll
                for (int bj = 0; bj < 2; ++bj)
#pragma unroll
                    for (int n = 0; n < 2; ++n) acc[ai][bj][m][n] = EPI_LD((const f32x4*)(rowp + bj * HALF + n * RC_N)); }
    }
    const float* x; float* out; bf16_t* X1B; const float* g2; float* SS; int midt;
    __device__ __forceinline__ int mid_t() const { return midt; }
    __device__ __forceinline__ void mid(f32x4 (&acc)[2][2][4][2], const Unit& u, int wr, int wc, int fr, int fq) const { add_residual_tile(acc, x, u, wr, wc, fr, fq); }
    __device__ __forceinline__ void fused(f32x4 (&acc)[2][2][4][2], const Unit& u, int wr, int wc, int fr, int fq, PG8_LAS unsigned char* lds, int wid, int lane) const {
        typedef unsigned u32x2v __attribute__((ext_vector_type(2)));
        PG8_LAS float* P = (PG8_LAS float*)lds;
        const __amdgpu_buffer_rsrc_t xrs = EPI_RSRC(X1B);
        const int col0 = u.pn * BM + wc * 32 + RC_FQ * fq;
        f32x4 gv[2][2];
#pragma unroll
        for (int bj = 0; bj < 2; ++bj)
#pragma unroll
            for (int n = 0; n < 2; ++n) gv[bj][n] = out ? *(const f32x4*)(g2 + col0 + bj * HALF + n * RC_N) : (f32x4){1.f, 1.f, 1.f, 1.f};
#pragma unroll
        for (int ai = 0; ai < 2; ++ai)
#pragma unroll
            for (int m = 0; m < 4; ++m) { const int r = ai * HALF + wr * 64 + m * 16 + fr; const size_t off = (size_t)(u.pm * BM + r) * 1024 + col0; float ss = 0.f;
#pragma unroll
                for (int bj = 0; bj < 2; ++bj)
#pragma unroll
                    for (int n = 0; n < 2; ++n) { const f32x4 v = acc[ai][bj][m][n];
                        if (out) *(f32x4*)(out + off + bj * HALF + n * RC_N) = v; ss += (v[0] * v[0] + v[1] * v[1]) + (v[2] * v[2] + v[3] * v[3]);
                        const f32x4 h = v * gv[bj][n]; u32x2v w; w.x = cvt_pk_safe(h[0], h[1]); w.y = cvt_pk_safe(h[2], h[3]); if (EPI_WT_Y) store_wt8(xrs, (unsigned)((off + bj * HALF + n * RC_N) * 2), w.x, w.y); else *(u32x2v*)(X1B + off + bj * HALF + n * RC_N) = w; }
                ss += __shfl_xor(ss, 16); ss += __shfl_xor(ss, 32);
                if (fq == 0) P[r * 4 + wc] = ss;
                if (m & 1) asm volatile("" ::: "memory"); }
        asm volatile("s_waitcnt lgkmcnt(0)" ::: "memory"); __builtin_amdgcn_s_barrier(); asm volatile("" ::: "memory");
        const int t = wid * 64 + lane;
        if (t < 256) { const float s = (P[t * 4 + 0] + P[t * 4 + 1]) + (P[t * 4 + 2] + P[t * 4 + 3]); SS[(size_t)(u.pm * BM + t) * 4 + u.pn] = s; }
    }
};

struct EpiGateUp {
    static constexpr bool INIT_ACC = false;
    static constexpr bool PERM = true, AFTER_DRAIN = false; static constexpr int MID_T = -1;
    const PG8_LAS float* R; bf16_t* U; int ldu;
    __device__ __forceinline__ void operator()(const f32x4 (&acc)[2][2][4][2], const Unit& u, int wr, int wc, int fr, int fq) const {
        asm volatile("" : "+v"(fr), "+v"(fq));
        const int row0 = u.pm * BM + wr * 64 + fr, col0 = u.pn * HALF + wc * 32 + 8 * fq;
        const __amdgpu_buffer_rsrc_t urs = __builtin_amdgcn_make_buffer_rsrc(U, 0, 0x7fffffff, 0x00020000);
#pragma unroll
        for (int ai = 0; ai < 2; ++ai)
#pragma unroll
            for (int m = 0; m < 4; ++m) { const size_t row = (size_t)(row0 + ai * HALF + m * 16);
                const float r = R[(row0 + ai * HALF + m * 16) & 2047];
                const float c1 = -LOG2E * r, c2 = r * r; u32x4 w;
#pragma unroll
                for (int n = 0; n < 2; ++n) { const f32x4 g4 = acc[ai][0][m][n], u4 = acc[ai][1][m][n];
#pragma unroll
                    for (int p = 0; p < 2; ++p) { const epi_f32x2 g = {g4[2 * p], g4[2 * p + 1]}, up = {u4[2 * p], u4[2 * p + 1]};
                        const epi_f32x2 a = g * c1; epi_f32x2 e = {__builtin_amdgcn_exp2f(a.x), __builtin_amdgcn_exp2f(a.y)}; e = e + 1.0f;
                        epi_f32x2 sg = {__builtin_amdgcn_rcpf(e.x), __builtin_amdgcn_rcpf(e.y)}; const epi_f32x2 hh = (g * up) * (sg * c2);
                        w[2 * n + p] = cvt_pk_safe(hh.x, hh.y); } }
                if (EPI_WT) store_wt16(urs, (unsigned)((row * ldu + col0) * 2), w); else EPI_ST((u32x4*)(U + row * ldu + col0), w); }
    }
};

struct EpiDown {
    static constexpr bool PERM = RES_PERM, AFTER_DRAIN = false; static constexpr int MID_T = EPI_INIT_ACC ? -1 : 0; static constexpr bool INIT_ACC = EPI_INIT_ACC;
    __device__ __forceinline__ void init_acc(f32x4 (&acc)[2][2][4][2], const Unit& u, int wr, int wc, int fr, int fq) const {
        if (x1b) add_residual_tile_bf16(acc, x1b, u, wr, wc, fr, fq); else add_residual_tile(acc, out, u, wr, wc, fr, fq);
    }
    float* out; int midt; const bf16_t* x1b;
    __device__ __forceinline__ int mid_t() const { return midt; }
    __device__ __forceinline__ void mid(f32x4 (&acc)[2][2][4][2], const Unit& u, int wr, int wc, int fr, int fq) const { if (x1b) add_residual_tile_bf16(acc, x1b, u, wr, wc, fr, fq); else add_residual_tile(acc, out, u, wr, wc, fr, fq); }
    __device__ __forceinline__ void operator()(const f32x4 (&acc)[2][2][4][2], const Unit& u, int wr, int wc, int fr, int fq) const {
        const int row0 = u.pm * BM + wr * 64 + fr, col0 = u.pn * BM + wc * 32 + RC_FQ * fq;
#pragma unroll
        for (int ai = 0; ai < 2; ++ai)
#pragma unroll
            for (int m = 0; m < 4; ++m) { float* rowp = out + (size_t)(row0 + ai * HALF + m * 16) * 1024 + col0;
#pragma unroll
                for (int bj = 0; bj < 2; ++bj)
#pragma unroll
                    for (int n = 0; n < 2; ++n) EPI_ST((f32x4*)(rowp + bj * HALF + n * RC_N), acc[ai][bj][m][n]); }
    }
};
#ifndef PG8_KSTAMP_BEGIN
#define PG8_KSTAMP_BEGIN() do {} while (0)
#define PG8_KSTAMP_END() do {} while (0)
#define PG8_KSTAMP_TRIP() do {} while (0)
#endif
#ifndef PG8_AUX_A
#define PG8_AUX_A 0
#endif
#ifndef PG8_AUX_B
#define PG8_AUX_B 0
#endif
template <class Epi, class Sched, bool ALIGN_EPI = false, bool SP2 = false>
__device__ __forceinline__ void gemm_phase(PG8_LAS unsigned char* lds, const Gemm g, const Sched& S, const Epi& E) {
    const int tid = threadIdx.x, wid = __builtin_amdgcn_readfirstlane(tid >> 6), lane = tid & 63, wr = wid >> 2, wc = wid & 3, fr = lane & 15, fq = lane >> 4;
    const int K = g.K, nt = K / BK;
    unsigned voffA[2], voffB[2];
#pragma unroll
    for (int i = 0; i < 2; ++i) { int R, C; stage_rc(tid * 16 + i * 8192, R, C); const int Rb = Epi::PERM ? ((R & ~31) + perm32(R & 31)) : R;
        voffA[i] = (unsigned)(R * K + C) * 2u; voffB[i] = (unsigned)(Rb * K + C) * 2u; }
    const size_t kstep = (size_t)(BK * 2);
    const size_t hstep = (size_t)HALF * K * 2;
    const size_t tstep = 2 * hstep;
    const unsigned ldsw = (unsigned)wid * 1024u;
    const int aoff = lds_byte(wr * 64 + fr, fq * 8), boff = lds_byte(wc * 32 + fr, fq * 8);
#define PG8_SA(b, h) (((b) * 2 + (h)) * HTB)
#define PG8_SB(b, h) ((4 + (b) * 2 + (h)) * HTB)
#define PG8_STAGE(bufoff, gbase, voff) do { _Pragma("unroll") for (int _i = 0; _i < 2; ++_i) { \
        if ((bufoff) >= 4 * HTB) __builtin_amdgcn_global_load_lds((const unsigned*)((const char*)(gbase) + (voff)[_i]), (PG8_LAS unsigned*)(lds + (bufoff) + ldsw + _i * 8192), 16, 0, PG8_AUX_B); \
        else __builtin_amdgcn_global_load_lds((const unsigned*)((const char*)(gbase) + (voff)[_i]), (PG8_LAS unsigned*)(lds + (bufoff) + ldsw + _i * 8192), 16, 0, PG8_AUX_A); } } while (0)
#define PG8_LDA(dst, b, h) do { _Pragma("unroll") for (int m = 0; m < 4; ++m) _Pragma("unroll") for (int k = 0; k < 2; ++k) dst[m][k] = *(const PG8_LAS bf16x8*)(lds + PG8_SA(b, h) + aoff + m * 2048 + k * 1024); } while (0)
#define PG8_LDB(dst, b, h) do { _Pragma("unroll") for (int n = 0; n < 2; ++n) _Pragma("unroll") for (int k = 0; k < 2; ++k) dst[n][k] = *(const PG8_LAS bf16x8*)(lds + PG8_SB(b, h) + boff + n * 2048 + k * 1024); } while (0)
#define PG8_MMA(ai, bj, At, Bt) do { __builtin_amdgcn_s_setprio(1); _Pragma("unroll") for (int m = 0; m < 4; ++m) _Pragma("unroll") for (int n = 0; n < 2; ++n) _Pragma("unroll") for (int k = 0; k < 2; ++k) \
        acc[ai][bj][m][n] = __builtin_amdgcn_mfma_f32_16x16x32_bf16(Bt[n][k], At[m][k], acc[ai][bj][m][n], 0, 0, 0); __builtin_amdgcn_s_setprio(0); } while (0)
#define PG8_WAIT_V(n) asm volatile("s_waitcnt vmcnt(" #n ")" ::: "memory")
#define PG8_WAIT_L(n) asm volatile("s_waitcnt lgkmcnt(" #n ")" ::: "memory")
#define PG8_BAR __builtin_amdgcn_s_barrier()
#define PG8_SCHED __builtin_amdgcn_sched_barrier(0)
    Unit cur, nxt; int ui = 0;
    if (!S.next(0, cur)) return;
    f32x4 acc[2][2][4][2];
#pragma unroll
    for (int a = 0; a < 2; ++a)
#pragma unroll
        for (int b = 0; b < 2; ++b)
#pragma unroll
            for (int m = 0; m < 4; ++m)
#pragma unroll
                for (int n = 0; n < 2; ++n) acc[a][b][m][n] = (f32x4){0.f, 0.f, 0.f, 0.f};
    if constexpr (Epi::INIT_ACC) E.init_acc(acc, cur, wr, wc, fr, fq);
    bf16x8 At[4][2], B0[2][2], B1[2][2];
    const char* cA = (const char*)g.A + (size_t)cur.pm * tstep; const char* cB = (const char*)g.Bt + (size_t)cur.pn * tstep;
    S.a_ready(cur);
    if constexpr (SP2) {
        PG8_STAGE(PG8_SB(0, 0), cB, voffB); PG8_STAGE(PG8_SB(0, 1), cB + hstep, voffB); PG8_STAGE(PG8_SA(0, 0), cA, voffA); PG8_STAGE(PG8_SA(0, 1), cA + hstep, voffA);
        if (wr == 1) PG8_BAR;
        PG8_WAIT_V(2); PG8_BAR;
        PG8_STAGE(PG8_SB(1, 0), cB + kstep, voffB); PG8_STAGE(PG8_SA(1, 0), cA + kstep, voffA); PG8_STAGE(PG8_SB(1, 1), cB + hstep + kstep, voffB);
        PG8_WAIT_V(6); PG8_BAR;
    } else {
        PG8_STAGE(PG8_SB(0, 0), cB, voffB); PG8_STAGE(PG8_SA(0, 0), cA, voffA); PG8_STAGE(PG8_SB(0, 1), cB + hstep, voffB); PG8_STAGE(PG8_SA(0, 1), cA + hstep, voffA);
        if (wr == 1) PG8_BAR;
        PG8_WAIT_V(4); PG8_BAR;
        PG8_STAGE(PG8_SB(1, 0), cB + kstep, voffB); PG8_STAGE(PG8_SA(1, 0), cA + kstep, voffA); PG8_STAGE(PG8_SB(1, 1), cB + hstep + kstep, voffB);
        PG8_WAIT_V(6); PG8_BAR;
    }
    for (;;) {
        const bool has_next = S.next(ui + 1, nxt);
        const char* nA = has_next ? (const char*)g.A + (size_t)nxt.pm * tstep : cA; const char* nB = has_next ? (const char*)g.Bt + (size_t)nxt.pn * tstep : cB;
        PG8_KSTAMP_BEGIN();
        for (int t = 0; t < nt; t += 2) {
            const bool last = (t == nt - 2);
            const char* a1 = cA + (size_t)(t + 1) * kstep;
            const char* a2 = last ? nA : cA + (size_t)(t + 2) * kstep; const char* b2 = last ? nB : cB + (size_t)(t + 2) * kstep;
            const char* a3 = a2 + kstep; const char* b3 = b2 + kstep;
            PG8_KSTAMP_TRIP();
            if (last && has_next) S.a_ready(nxt);
            if constexpr (Epi::MID_T >= 0) { if (t == E.mid_t()) E.mid(acc, cur, wr, wc, fr, fq); }
            if constexpr (SP2) {
            PG8_LDB(B0, 0, 0); PG8_LDB(B1, 0, 1); PG8_SCHED; PG8_LDA(At, 0, 0); PG8_STAGE(PG8_SA(1, 1), a1 + hstep, voffA);
            PG8_WAIT_V(8); PG8_WAIT_L(0); PG8_BAR; PG8_MMA(0, 0, At, B0); PG8_MMA(0, 1, At, B1); PG8_BAR; PG8_SCHED;
            PG8_LDA(At, 0, 1); PG8_STAGE(PG8_SB(0, 0), b2, voffB); PG8_STAGE(PG8_SB(0, 1), b2 + hstep, voffB); PG8_STAGE(PG8_SA(0, 0), a2, voffA);
            PG8_WAIT_V(8); PG8_WAIT_L(0); PG8_BAR; PG8_MMA(1, 0, At, B0); PG8_MMA(1, 1, At, B1); PG8_BAR; PG8_SCHED;
            PG8_LDB(B0, 1, 0); PG8_LDB(B1, 1, 1); PG8_SCHED; PG8_LDA(At, 1, 0); PG8_STAGE(PG8_SA(0, 1), a2 + hstep, voffA);
            PG8_WAIT_V(8); PG8_WAIT_L(0); PG8_BAR; PG8_MMA(0, 0, At, B0); PG8_MMA(0, 1, At, B1); PG8_BAR; PG8_SCHED;
            PG8_LDA(At, 1, 1); PG8_STAGE(PG8_SB(1, 0), b3, voffB); PG8_STAGE(PG8_SB(1, 1), b3 + hstep, voffB); PG8_STAGE(PG8_SA(1, 0), a3, voffA);
            PG8_WAIT_V(8); PG8_WAIT_L(0); PG8_BAR; PG8_MMA(1, 0, At, B0); PG8_MMA(1, 1, At, B1); PG8_BAR; PG8_SCHED;
            } else {
            PG8_LDB(B0, 0, 0); PG8_SCHED; PG8_LDA(At, 0, 0); PG8_STAGE(PG8_SA(1, 1), a1 + hstep, voffA);
            PG8_WAIT_L(8); PG8_BAR; PG8_WAIT_L(0); PG8_MMA(0, 0, At, B0); PG8_BAR; PG8_SCHED;
            PG8_LDB(B1, 0, 1); PG8_STAGE(PG8_SB(0, 0), b2, voffB);
            PG8_BAR; PG8_WAIT_L(0); PG8_MMA(0, 1, At, B1); PG8_BAR;
            PG8_LDA(At, 0, 1); PG8_STAGE(PG8_SA(0, 0), a2, voffA);
            PG8_BAR; PG8_WAIT_L(0); PG8_MMA(1, 0, At, B0); PG8_BAR; PG8_SCHED;
            PG8_STAGE(PG8_SB(0, 1), b2 + hstep, voffB);
            PG8_WAIT_V(6); PG8_BAR; PG8_MMA(1, 1, At, B1); PG8_BAR;
            PG8_LDB(B0, 1, 0); PG8_SCHED; PG8_LDA(At, 1, 0); PG8_STAGE(PG8_SA(0, 1), a2 + hstep, voffA);
            PG8_WAIT_L(8); PG8_BAR; PG8_WAIT_L(0); PG8_MMA(0, 0, At, B0); PG8_BAR; PG8_SCHED;
            PG8_LDB(B1, 1, 1); PG8_STAGE(PG8_SB(1, 0), b3, voffB);
            PG8_BAR; PG8_WAIT_L(0); PG8_MMA(0, 1, At, B1); PG8_BAR;
            PG8_LDA(At, 1, 1); PG8_STAGE(PG8_SA(1, 0), a3, voffA);
            PG8_BAR; PG8_WAIT_L(0); PG8_MMA(1, 0, At, B0); PG8_BAR; PG8_SCHED;
            PG8_STAGE(PG8_SB(1, 1), b3 + hstep, voffB);
            PG8_WAIT_V(6); PG8_BAR; PG8_MMA(1, 1, At, B1); PG8_BAR;
            }
        }
        PG8_KSTAMP_END();
        if constexpr (ALIGN_EPI) { if (wr == 0) PG8_BAR; }
        if constexpr (!Epi::AFTER_DRAIN) { E(acc, cur, wr, wc, fr, fq); S.done(cur); }
        if (!has_next) break;
#pragma unroll
        for (int a = 0; a < 2; ++a)
#pragma unroll
            for (int b = 0; b < 2; ++b)
#pragma unroll
                for (int m = 0; m < 4; ++m)
#pragma unroll
                    for (int n = 0; n < 2; ++n) acc[a][b][m][n] = (f32x4){0.f, 0.f, 0.f, 0.f};
        cur = nxt; cA = nA; cB = nB; ++ui;
        if constexpr (ALIGN_EPI) { if (wr == 1) PG8_BAR; }
    }
    PG8_WAIT_V(0);
    if constexpr (!ALIGN_EPI) { if (wr == 0) PG8_BAR; }
    PG8_BAR;
    if constexpr (Epi::AFTER_DRAIN) { E.fused(acc, cur, wr, wc, fr, fq, lds, wid, lane); S.done(cur); }
#undef PG8_SA
#undef PG8_SB
#undef PG8_STAGE
#undef PG8_LDA
#undef PG8_LDB
#undef PG8_MMA
#undef PG8_WAIT_V
#undef PG8_WAIT_L
#undef PG8_BAR
#undef PG8_SCHED
}
}
#ifdef MK_STAMP_A
#define ATT_SUBSTAMP() do { if (tid == 0) ((ATT_LAS unsigned*)(lds + (155648 - 1024) + 64))[att_ns] = (unsigned)__builtin_amdgcn_s_memrealtime(); ++att_ns; } while (0)
#endif
#ifndef ATT_KVLD
#define ATT_KVLD(p) (*(p))
#endif
#ifndef ATT_SUBSTAMP
#define ATT_SUBSTAMP() do {} while (0)
#endif
namespace att {
typedef unsigned short bf16_t;
typedef short bf16x8 __attribute__((ext_vector_type(8)));
typedef short s16x4 __attribute__((ext_vector_type(4)));
typedef float f32x16 __attribute__((ext_vector_type(16)));
typedef float f32x2_t __attribute__((ext_vector_type(2)));
typedef __bf16 bf16x2_t __attribute__((ext_vector_type(2)));
typedef unsigned u32x4 __attribute__((ext_vector_type(4)));
typedef unsigned u32x2 __attribute__((ext_vector_type(2)));
#define ATT_LAS __attribute__((address_space(3)))
constexpr int T = 8192;
constexpr float LOG2E = 1.4426950408889634f;
constexpr float NEG_BIG = -1.0e30f;
constexpr int B_K = 0, B_VT = 49152, B_VT_PITCH = 784, B_TAB = B_VT + 64 * B_VT_PITCH  , B_TAB_N = 320;
constexpr int MISC = B_TAB + 4 * B_TAB_N * 4;
constexpr int A_TAB = MISC + 64;
constexpr int O_STAGE = A_TAB + 8192, O_STAGE_PITCH = 144, O_STAGE_WAVE = 32 * O_STAGE_PITCH;
static_assert(A_TAB % 16 == 0 && O_STAGE % 16 == 0, "attention LDS map");
__device__ __forceinline__ int kappa(int r) { return (r & 19) | ((r & 4) << 1) | ((r & 8) >> 1); }
__device__ __forceinline__ int kcol0(int i) { return (i & 7) + 16 * (i >> 3); }
__device__ __forceinline__ int crow(int i, int h) { return (i & 3) + 8 * (i >> 2) + 4 * h; }
__device__ __forceinline__ unsigned cvtpk(float lo, float hi) { f32x2_t v = {lo, hi}; bf16x2_t b = __builtin_convertvector(v, bf16x2_t); return __builtin_bit_cast(unsigned, b); }
__device__ __forceinline__ bf16x8 pack8(const float* e) { u32x4 p; p.x = cvtpk(e[0], e[1]); p.y = cvtpk(e[2], e[3]); p.z = cvtpk(e[4], e[5]); p.w = cvtpk(e[6], e[7]); return __builtin_bit_cast(bf16x8, p); }
__device__ __forceinline__ bf16x8 cat4(s16x4 a, s16x4 b) { return (bf16x8){a[0], a[1], a[2], a[3], b[0], b[1], b[2], b[3]}; }
__device__ __forceinline__ int clampi(int v, int lo, int hi) { return v < lo ? lo : (v > hi ? hi : v); }
__device__ __forceinline__ float wave_max(float v) {
#pragma unroll
    for (int o = 1; o < 64; o <<= 1) v = fmaxf(v, __shfl_xor(v, o));
    return v;
}
#define ATT_MFMA(a, b, c) __builtin_amdgcn_mfma_f32_32x32x16_bf16((a), (b), (c), 0, 0, 0)

struct Tensors {
    const bf16_t *QA, *KA, *VAT, *QB, *KB, *VBT; bf16_t *OA, *OB;
    const float *rpb, *qna, *kna, *qnb, *knb, *sink, *t5;
};

__device__ __forceinline__ int t5_bucket(int rel) {
    const int n = rel < 0 ? -rel : rel;
    const int large = 8 + (n >= 12) + (n >= 16) + (n >= 23) + (n >= 32) + (n >= 46) + (n >= 64) + (n >= 91);
    return (rel > 0 ? 16 : 0) + (n < 8 ? n : large);
}

template <class TokF> __device__ __forceinline__ void store_o(ATT_LAS unsigned char* stg, bf16_t* obase  , TokF tok, const f32x16& o0, const f32x16& o1, float il, int lane) {
    const int r = lane & 31, hi = lane >> 5;
#pragma unroll
    for (int g = 0; g < 4; ++g) {
        u32x2 w0, w1;
        w0.x = cvtpk(o0[4 * g] * il, o0[4 * g + 1] * il); w0.y = cvtpk(o0[4 * g + 2] * il, o0[4 * g + 3] * il);
        w1.x = cvtpk(o1[4 * g] * il, o1[4 * g + 1] * il); w1.y = cvtpk(o1[4 * g + 2] * il, o1[4 * g + 3] * il);
        *(ATT_LAS u32x2*)(stg + r * O_STAGE_PITCH + (8 * g + 4 * hi) * 2) = w0; *(ATT_LAS u32x2*)(stg + r * O_STAGE_PITCH + 64 + (8 * g + 4 * hi) * 2) = w1;
    }
#pragma unroll
    for (int i = 0; i < 4; ++i) { const int q = (lane >> 3) + 8 * i, c = lane & 7;
        const u32x4 v = *(const ATT_LAS u32x4*)(stg + q * O_STAGE_PITCH + c * 16);
        *(u32x4*)(obase + (size_t)tok(q) * 1024 + c * 8) = v; }
}

__device__ __forceinline__ void natten_quad(const Tensors& A, const ATT_LAS float* tab  , ATT_LAS unsigned char* stg  , int b, int h, int j, int v, int lane) {
    const int r = lane & 31, hi = lane >> 5;
    const int R0 = 4 * v, qc = 16 * j + (r & 15);
    const int kr_lo = clampi(R0 - 4, 0, 120), kr_hi = clampi(R0 - 1, 0, 120) + 7, nrows = kr_hi - kr_lo + 1;
    const int ss = clampi(16 * j - 8, 0, 32), ws = clampi(qc - 8, 0, 48);
    const int qrow0 = R0 + (r >> 4), qrow1 = R0 + 2 + (r >> 4);
    const int rsq0 = clampi(qrow0 - 4, 0, 120), rsq1 = clampi(qrow1 - 4, 0, 120);
    const int lo0 = clampi(R0 - 4, 0, 120), hi0 = clampi(R0 - 3, 0, 120) + 8, lo1 = clampi(R0 - 2, 0, 120), hi1 = clampi(R0 - 1, 0, 120) + 8;
    const size_t mq0 = (size_t)b * T + qrow0 * 64 + qc, mq1 = mq0 + 128;
    bf16x8 qf0[4], qf1[4];
#pragma unroll
    for (int s = 0; s < 4; ++s) { qf0[s] = __builtin_nontemporal_load((const bf16x8*)(A.QA + mq0 * 512 + h * 64 + 16 * s + 8 * hi));
                                  qf1[s] = __builtin_nontemporal_load((const bf16x8*)(A.QA + mq1 * 512 + h * 64 + 16 * s + 8 * hi)); }
    f32x16 oa0, oa1, ob0, ob1;
#pragma unroll
    for (int i = 0; i < 16; ++i) { oa0[i] = 0.f; oa1[i] = 0.f; ob0[i] = 0.f; ob1[i] = 0.f; }
    float lsa = 0.f, lsb = 0.f;
    const int cmask0 = ss + 8 * hi - ws;
    const int dcol0 = ss + 8 * hi - qc + 31;
    const int tk0 = kr_lo * 64 + ss + kappa(r);
    const bf16_t* kbase = A.KA + ((size_t)(b * 1024 * 8 + h) * 64 + hi * 8 + (tk0 & 7)) * 8 + (size_t)(tk0 >> 3) * (8 * 512);
    const bf16_t* vbase = A.VAT + ((size_t)(b * 1024 * 8 + h) * 64 + r) * 8 + (size_t)((kr_lo * 64 + ss + 8 * hi) >> 3) * (8 * 512);
    bf16x8 ka[4], va[4], kb[4], vb[4];
#define ATT_LOADKV(KF, VF, kr_) do { const int krc_ = (kr_) < nrows ? (kr_) : nrows - 1; const size_t ko_ = (size_t)krc_ * (8 * 8 * 512); \
        _Pragma("unroll") for (int s = 0; s < 4; ++s) KF[s] = ATT_KVLD((const bf16x8*)(kbase + ko_ + s * 128)); \
        _Pragma("unroll") for (int dt = 0; dt < 2; ++dt) _Pragma("unroll") for (int s2 = 0; s2 < 2; ++s2) VF[dt * 2 + s2] = ATT_KVLD((const bf16x8*)(vbase + ko_ + dt * 256 + s2 * (2 * 8 * 512))); } while (0)
#define ATT_BLOCK(KF, VF, QF, O0, O1, LS, QROW, RSQ) do { \
        const bool rowok = (krow >= (RSQ)) && (krow < (RSQ) + 8); \
        const ATT_LAS float* tp = tab + (rowok ? (krow - (QROW) + 7) : 15) * 64 + dcol0; \
        float bv[16]; _Pragma("unroll") for (int i = 0; i < 16; ++i) bv[i] = tp[kcol0(i)]; \
        f32x16 x; _Pragma("unroll") for (int i = 0; i < 16; ++i) x[i] = 0.f; \
        _Pragma("unroll") for (int s = 0; s < 4; ++s) x = ATT_MFMA(KF[s], QF[s], x); \
        float e[16]; \
        _Pragma("unroll") for (int i = 0; i < 16; ++i) { const float v_ = __builtin_amdgcn_exp2f(x[i] + bv[i]); e[i] = ((unsigned)(cmask0 + kcol0(i)) < 16u) ? v_ : 0.f; LS += e[i]; } \
        _Pragma("unroll") for (int s2 = 0; s2 < 2; ++s2) { const bf16x8 xs = pack8(e + 8 * s2); O0 = ATT_MFMA(VF[s2], xs, O0); O1 = ATT_MFMA(VF[2 + s2], xs, O1); } } while (0)
#define ATT_ROW(KF, VF, kr_) do { const int krow = kr_lo + (kr_); \
        if (krow >= lo0 && krow < hi0) ATT_BLOCK(KF, VF, qf0, oa0, oa1, lsa, qrow0, rsq0);        \
        if (krow >= lo1 && krow < hi1) ATT_BLOCK(KF, VF, qf1, ob0, ob1, lsb, qrow1, rsq1); } while (0)
    ATT_LOADKV(ka, va, 0);
    for (int kr = 0; kr < nrows; kr += 2) {
        ATT_LOADKV(kb, vb, kr + 1);
        ATT_ROW(ka, va, kr);
        ATT_LOADKV(ka, va, kr + 2);
        ATT_ROW(kb, vb, kr + 1);
    }
#undef ATT_ROW
#undef ATT_LOADKV
#undef ATT_BLOCK
    lsa += __shfl_xor(lsa, 32); lsb += __shfl_xor(lsb, 32);
    { const size_t tb0 = (size_t)b * T + R0 * 64 + 16 * j;
      store_o(stg, A.OA + h * 64, [&](int q) { return tb0 + (q >> 4) * 64 + (q & 15); }, oa0, oa1, 1.0f / lsa, lane);
      store_o(stg, A.OA + h * 64, [&](int q) { return tb0 + 128 + (q >> 4) * 64 + (q & 15); }, ob0, ob1, 1.0f / lsb, lane); }
}

__device__ __forceinline__ void swa_stage(ATT_LAS unsigned char* lds, const Tensors& A, int b, int n, int kvh, int tid) {
#pragma unroll
    for (int i = 0; i < 6; ++i) { const int c = tid + 512 * i, tbw = c >> 6, ch = (c >> 3) & 7, ti = c & 7, w = tbw * 8 + ti; const int tok = clampi(n * 128 - 128 + w, 0, T - 1);
        const u32x4 v = *(const u32x4*)(A.KB + ((size_t)((b * 1024 + (tok >> 3)) * 2 + kvh) * 64 + ch * 8 + (tok & 7)) * 8);
        *(ATT_LAS u32x4*)(lds + B_K + w * 128 + ((ch ^ ((w >> 1) & 7)) << 4)) = v; }
#pragma unroll
    for (int i = 0; i < 6; ++i) { const int c = tid + 512 * i, tbw = c >> 6, d = c & 63; const int tb = n * 16 - 16 + tbw;
        u32x4 v = (u32x4){0u, 0u, 0u, 0u};
        if (tb >= 0 && tb < T / 8) v = *(const u32x4*)(A.VBT + ((size_t)((b * 1024 + tb) * 2 + kvh) * 64 + d) * 8);
        *(ATT_LAS u32x4*)(lds + B_VT + d * B_VT_PITCH + tbw * 16) = v; }
}
__device__ __forceinline__ void swa_compute(ATT_LAS unsigned char* lds, ATT_LAS unsigned char* stg  , const Tensors& A, int b, int n, int kvh, int g, int sb0, int lane) {
    const ATT_LAS float* misc = (const ATT_LAS float*)(lds + MISC);
    const int head = kvh * 4 + g, r = lane & 31, hi = lane >> 5;
    const ATT_LAS float* tabg = (const ATT_LAS float*)(lds + B_TAB) + g * B_TAB_N;
    const int kap = kappa(r), kswz = (kap >> 1) & 7;
#pragma unroll 1
    for (int sb = sb0; sb < sb0 + 2; ++sb) {
        const size_t mq = (size_t)b * T + n * 128 + 32 * sb + r;
        bf16x8 qf[4];
#pragma unroll
        for (int s = 0; s < 4; ++s) qf[s] = __builtin_nontemporal_load((const bf16x8*)(A.QB + mq * 512 + head * 64 + 16 * s + 8 * hi));
        f32x16 o0, o1;
#pragma unroll
        for (int i = 0; i < 16; ++i) { o0[i] = 0.f; o1[i] = 0.f; }
        float lsum = 0.f;
        const int kt_lo = sb > ((n == 0) ? 4 : 0) ? sb : ((n == 0) ? 4 : 0);
        const int kt_hi = (sb + 8) < ((n == T / 128 - 1) ? 7 : 11) ? (sb + 8) : ((n == T / 128 - 1) ? 7 : 11);
        for (int kt = kt_lo; kt <= kt_hi; ++kt) {
            const ATT_LAS float* tp = tabg + 32 * (kt - sb) + 32 - r + 8 * hi;
            const ATT_LAS unsigned char* kp = lds + B_K + (32 * kt + kap) * 128;
            bf16x8 kf[4];
#pragma unroll
            for (int s = 0; s < 4; ++s) kf[s] = *(const ATT_LAS bf16x8*)(kp + (((2 * s + hi) ^ kswz) << 4));
            float bv[16];
#pragma unroll
            for (int i = 0; i < 16; ++i) bv[i] = tp[kcol0(i)];
            f32x16 x;
#pragma unroll
            for (int i = 0; i < 16; ++i) x[i] = 0.f;
#pragma unroll
            for (int s = 0; s < 4; ++s) x = ATT_MFMA(kf[s], qf[s], x);
            float e[16];
#pragma unroll
            for (int i = 0; i < 16; ++i) { e[i] = __builtin_amdgcn_exp2f(x[i] + bv[i]); lsum += e[i]; }
            const ATT_LAS unsigned char* vp = lds + B_VT + r * B_VT_PITCH + (32 * kt + 8 * hi) * 2;
#pragma unroll
            for (int s2 = 0; s2 < 2; ++s2) { const bf16x8 xs = pack8(e + 8 * s2);
                const bf16x8 a0 = *(const ATT_LAS bf16x8*)(vp + 32 * s2), c0 = *(const ATT_LAS bf16x8*)(vp + 32 * B_VT_PITCH + 32 * s2);
                o0 = ATT_MFMA(a0, xs, o0); o1 = ATT_MFMA(c0, xs, o1); }
        }
        lsum += __shfl_xor(lsum, 32);
        lsum += misc[12 + g];
        { const size_t tb0 = (size_t)b * T + n * 128 + 32 * sb; store_o(stg, A.OB + head * 64, [&](int q) { return tb0 + q; }, o0, o1, 1.0f / lsum, lane); }
    }
}

constexpr int TAB_A_FLOATS = 8 * 16 * 64, TAB_B_FLOATS = 8 * B_TAB_N, TAB_FLOATS = TAB_A_FLOATS + TAB_B_FLOATS + 8;
__device__ __forceinline__ void build_tables(ATT_LAS unsigned char* lds, float* tabs, const Tensors& A, int h, int tid, int wid, int lane) {
    ATT_LAS float* misc = (ATT_LAS float*)lds;
    if (wid == 0) { float mx = 0.f;
        for (int i = lane; i < 15 * 31; i += 64) mx = fmaxf(mx, fabsf(A.rpb[i * 8 + h]));
        mx = wave_max(mx); const float gq = wave_max(fabsf(A.qna[lane])), gk = wave_max(fabsf(A.kna[lane]));
        if (lane == 0) misc[0] = 8.0f * gq * gk * 1.02f + mx;
    } else if (wid == 1) { float mx = lane < 32 ? fabsf(A.t5[lane * 8 + h]) : 0.f;
        mx = wave_max(mx); const float gq = wave_max(fabsf(A.qnb[lane])), gk = wave_max(fabsf(A.knb[lane]));
        const float sk = A.sink[h], M = fmaxf(8.0f * gq * gk * 1.02f + mx, sk);
        if (lane == 0) { misc[1] = M; tabs[TAB_A_FLOATS + TAB_B_FLOATS + h] = __builtin_amdgcn_exp2f((sk - M) * LOG2E); }
    }
    __syncthreads();
    for (int idx = tid; idx < 16 * 64; idx += 512) { const int row = idx >> 6, dc = (idx & 63) - 16; float v = NEG_BIG;
        if (row < 15 && dc >= 0 && dc <= 30) v = (A.rpb[(row * 31 + dc) * 8 + h] - misc[0]) * LOG2E;
        tabs[h * 1024 + idx] = v; }
    for (int idx = tid; idx < B_TAB_N; idx += 512) { const int rel = idx - 160; float v = NEG_BIG;
        if (rel >= -128 && rel <= 128) v = (A.t5[t5_bucket(rel) * 8 + h] - misc[1]) * LOG2E;
        tabs[TAB_A_FLOATS + h * B_TAB_N + idx] = v; }
    __syncthreads();
}

__device__ __forceinline__ void attn_phase(ATT_LAS unsigned char* lds, const Tensors& A, const float* tabs, int vcu, int tid, int wid, int lane) {
    int att_ns = 0; (void)att_ns;
    ATT_LAS float* misc = (ATT_LAS float*)(lds + MISC);
    const int b = vcu >> 7, v = (vcu & 127) >> 2, hp = vcu & 3, n = 2 * v + (hp & 1), kvh = hp >> 1;
    {
        ((ATT_LAS u32x4*)(lds + A_TAB))[tid] = ((const u32x4*)(tabs + 2 * hp * 1024))[tid];
        if (tid < B_TAB_N) ((ATT_LAS u32x4*)(lds + B_TAB))[tid] = ((const u32x4*)(tabs + TAB_A_FLOATS + 4 * kvh * B_TAB_N))[tid];
        if (tid < 4) misc[12 + tid] = tabs[TAB_A_FLOATS + TAB_B_FLOATS + 4 * kvh + tid];
    }
    swa_stage(lds, A, b, n, kvh, tid);
    __syncthreads();
    ATT_SUBSTAMP();
    natten_quad(A, (const ATT_LAS float*)(lds + A_TAB) + (wid & 1) * 1024, lds + O_STAGE + wid * O_STAGE_WAVE, b, 2 * hp + (wid & 1), wid >> 1, v, lane);
    ATT_SUBSTAMP();
    swa_compute(lds, lds + O_STAGE + wid * O_STAGE_WAVE, A, b, n, kvh, wid & 3, 2 * (wid >> 2), lane);
    __syncthreads();
}
}

#ifndef PG8_SP2
#define PG8_SP2 true
#endif
#ifndef PG8_ALIGN
#define PG8_ALIGN true
#endif

#ifndef MK_REPEAT
#define MK_REPEAT (-1)
#endif
#ifndef MK_BF16_RESID
#define MK_BF16_RESID 1
#endif
#ifndef MK_CODE_PREFETCH
#define MK_CODE_PREFETCH 0
#endif
#define MK_CODE_BYTES 94208
#ifndef MK_WGM_P1
#define MK_WGM_P1 4
#endif
#ifndef MK_WGM_P5
#define MK_WGM_P5 4
#endif
#ifndef MK_HOOK4
#define MK_HOOK4(v) (2 + 2 * ((v) % 6))
#endif
#ifndef MK_HOOK6
#define MK_HOOK6(v) (2 + 2 * ((v) % 20))
#endif
#ifndef MK_GROUP_BAR
#define MK_GROUP_BAR 1
#endif
constexpr int NWAVES = 8;
constexpr int N_PHASES = 7;
constexpr int BATCH = 2, T = 8192, D = 1024, M = BATCH * T, FF = 2816, NIN = 4352, AW = 512;
constexpr size_t MiB = 1u << 20;
constexpr size_t WS_CTL = 0, CTL_ZERO_BYTES = 1 * MiB;
constexpr size_t WS_WIN = 1 * MiB;
constexpr size_t WS_WB = WS_WIN + (size_t)NIN * D * 2;
constexpr size_t WS_WO = WS_WB + (size_t)D * D * 2;
constexpr size_t WS_WGU = WS_WO + (size_t)D * D * 2;
constexpr size_t WS_WD = WS_WGU + (size_t)2 * FF * D * 2;
constexpr size_t WS_WEND = WS_WD + (size_t)D * FF * 2;
constexpr size_t WS_RS1 = 30 * MiB, WS_SS = 30 * MiB + 512 * 1024;
constexpr size_t WS_TABS = 31 * MiB;
constexpr size_t WS_XN = 32 * MiB;
constexpr size_t WS_Y = WS_XN;
constexpr size_t WS_QA = 64 * MiB, WS_KA = 80 * MiB, WS_VAT = 96 * MiB, WS_QB = 112 * MiB, WS_KB = 128 * MiB, WS_VBT = 132 * MiB;
constexpr size_t WS_GATE = 136 * MiB;
constexpr size_t WS_OA = 200 * MiB, WS_OB = WS_OA + 512 * 2;
constexpr size_t WS_X1B = WS_OA;
constexpr size_t WS_U = 64 * MiB;
constexpr size_t WS_END = 256 * MiB;
static_assert(WS_WEND <= WS_RS1 && WS_SS + (size_t)M * 16 <= WS_XN && WS_U + (size_t)M * FF * 2 <= WS_OA && WS_OA + (size_t)M * D * 2 <= WS_END, "d_ws map");
constexpr int CW_TMO = 0, CW_CODE = 1, CW_BAR = 4096, CW_GRP = 12288, CW_XCC = 8192;

constexpr int RING_OFF = 0, RING_BYTES = 131072;
constexpr int LDS_BYTES = 155648;
constexpr int LDSCTL_OFF = LDS_BYTES - 1024, MISC_OFF = LDSCTL_OFF + 320;
constexpr int EPI_TAB_OFF = RING_BYTES;
static_assert(MISC_OFF + 128 <= LDS_BYTES && EPI_TAB_OFF + 1024 + 8 * 2304 <= LDSCTL_OFF && EPI_TAB_OFF + 8192 <= LDSCTL_OFF && att::O_STAGE + 8 * att::O_STAGE_WAVE <= LDSCTL_OFF, "LDS map");

#define GAS __attribute__((address_space(1)))
#define LAS __attribute__((address_space(3)))
typedef unsigned short bf16;
typedef unsigned v4u __attribute__((ext_vector_type(4)));
typedef float f32x4 __attribute__((ext_vector_type(4)));
typedef short bf16x8 __attribute__((ext_vector_type(8)));
typedef GAS unsigned gu32;
typedef GAS unsigned long long gu64;
#define RLX_AGENT __ATOMIC_RELAXED, __HIP_MEMORY_SCOPE_AGENT
#define LDS_WAIT() asm volatile("s_waitcnt lgkmcnt(0)" ::: "memory")
#define VM_WAIT() asm volatile("s_waitcnt vmcnt(0)" ::: "memory")
__device__ __forceinline__ unsigned long long rt() { return __builtin_amdgcn_s_memrealtime(); }
__device__ __forceinline__ unsigned f2bf(float f) { unsigned u = __builtin_bit_cast(unsigned, f); return (u + 0x7fffu + ((u >> 16) & 1u)) >> 16; }
__device__ __forceinline__ unsigned pk2(float lo, float hi) { return f2bf(lo) | (f2bf(hi) << 16); }
#define XB_TMO      128
#define XB_XCNT(j)  (256  + 64 * (j))
#define XB_XSUB(j)  (1280 + 64 * (j))
#define XB_XGEN(j)  (2304 + 64 * (j))
#define XB_TOP      3328
#define XB_TOPGEN   3392
#define XCD_BAR_WORDS 3456
#define XB_SPIN_CAP (1u << 18)

__device__ __forceinline__ unsigned xb_ld(unsigned* p)              { return __hip_atomic_load(p, __ATOMIC_RELAXED, __HIP_MEMORY_SCOPE_AGENT); }
__device__ __forceinline__ unsigned xb_add(unsigned* p, unsigned v) { return __hip_atomic_fetch_add(p, v, __ATOMIC_RELAXED, __HIP_MEMORY_SCOPE_AGENT); }
__device__ __forceinline__ unsigned xb_xcc_id() { return (unsigned)__builtin_amdgcn_s_getreg((3 << 11) | 20) & 0xFu; }
#define XB_SPIN(cond, bar) do { unsigned _sp = 0; while (cond) { __builtin_amdgcn_s_sleep(1); \
    if ((++_sp & 255u) == 0u) { if (xb_ld(&(bar)[XB_TMO])) break; if (_sp > XB_SPIN_CAP) { atomicAdd(&(bar)[XB_TMO], 1u); break; } } } } while (0)

struct XcdBarrier {
    unsigned* bar; unsigned x;
    volatile LAS unsigned* st;
};

__device__ __forceinline__ XcdBarrier xcd_barrier_post(unsigned* bar, volatile LAS unsigned* st) {
    XcdBarrier b; b.bar = bar; b.x = xb_xcc_id(); b.st = st;
    if (threadIdx.x == 0) (void)xb_add(&bar[XB_XCNT(b.x)], 1u);
    return b;
}
__device__ __forceinline__ void xcd_barrier_complete(unsigned* bar, unsigned x, unsigned& nloc, unsigned& nx) {
    const unsigned G = gridDim.x * gridDim.y * gridDim.z;
    unsigned sum, cnt, mine, sp = 0u;
    for (;;) {
        sum = 0u; cnt = 0u; mine = 0u;
#pragma unroll
        for (unsigned j = 0; j < 16; ++j) { const unsigned c = xb_ld(&bar[XB_XCNT(j)]); sum += c; cnt += (c > 0u) ? 1u : 0u; mine = (j == x) ? c : mine; }
        if (sum == G) break;
        __builtin_amdgcn_s_sleep(1);
        if ((++sp & 255u) == 0u) { if (xb_ld(&bar[XB_TMO])) break; if (sp > XB_SPIN_CAP) { atomicAdd(&bar[XB_TMO], 1u); break; } }
    }
    nloc = mine > 0u ? mine : 1u; nx = cnt > 0u ? cnt : 1u;
}

__device__ __forceinline__ void xcd_barrier(const XcdBarrier& b) {
    asm volatile("s_waitcnt vmcnt(0)" ::: "memory");
    __syncthreads();
    if (threadIdx.x == 0) {
        unsigned* bar = b.bar;
        __builtin_amdgcn_s_waitcnt(0);
        unsigned nloc = b.st[0], nx = b.st[1];
        if (nloc == 0u) { xcd_barrier_complete(bar, b.x, nloc, nx); b.st[0] = nloc; b.st[1] = nx; }
        const unsigned old = xb_add(&bar[XB_XSUB(b.x)], 1u);
        const unsigned gen = old / nloc;
        if (old + 1u == (gen + 1u) * nloc) {
            __builtin_amdgcn_fence(__ATOMIC_RELEASE, "agent");
            asm volatile("s_waitcnt vmcnt(0)" ::: "memory");
            const unsigned og = xb_add(&bar[XB_TOP], 1u);
            const unsigned tg = og / nx;
            if (og + 1u == (tg + 1u) * nx) xb_add(&bar[XB_TOPGEN], 1u);
            else XB_SPIN(xb_ld(&bar[XB_TOPGEN]) == tg, bar);
            __builtin_amdgcn_fence(__ATOMIC_ACQUIRE, "agent");
            xb_add(&bar[XB_XGEN(b.x)], 1u);
            asm volatile("s_waitcnt vmcnt(0)" ::: "memory");
        } else {
            XB_SPIN(xb_ld(&bar[XB_XGEN(b.x)]) == gen, bar);
            __builtin_amdgcn_fence(__ATOMIC_ACQUIRE, "agent");
            asm volatile("s_waitcnt vmcnt(0)" ::: "memory");
        }
    }
    __syncthreads();
}


__device__ __forceinline__ void group_barrier(gu32* cnt, unsigned target, gu32* tmo) {
    asm volatile("s_waitcnt vmcnt(0)" ::: "memory");
    __syncthreads();
    if (threadIdx.x == 0) {
        (void)__hip_atomic_fetch_add(cnt, 1u, RLX_AGENT);
        unsigned sp = 0u;
        while (__hip_atomic_load(cnt, RLX_AGENT) < target) { __builtin_amdgcn_s_sleep(1);
            if ((++sp & 255u) == 0u) { if (__hip_atomic_load(tmo, RLX_AGENT)) break; if (sp > (1u << 18)) { __hip_atomic_store(tmo, 1u, RLX_AGENT); break; } } }
        __builtin_amdgcn_fence(__ATOMIC_ACQUIRE, "agent");
        asm volatile("s_waitcnt vmcnt(0)" ::: "memory");
    }
    __syncthreads();
}

struct Frame {
    LAS unsigned char* lds; volatile LAS unsigned* MISC; gu32* ctl;
    int tid, lane, wave, vcu, G;
};
struct Args { const float* in[17]; float* out; unsigned char* ws; int ph_lo, ph_hi; };
static_assert(sizeof(Args) == 17 * 8 + 8 + 8 + 8, "Args has no padding");

__device__ __forceinline__ float wave_sum(float v) {
#pragma unroll
    for (int o = 1; o < 64; o <<= 1) v += __shfl_xor(v, o);
    return v;
}
__device__ __forceinline__ const float* OPQ(const float* p) { asm volatile("" : "+s"(p)); return p; }
struct P0Item { const float* W; bf16* WT; const float* kscale; int ldk, N, k0, n0, drow0, kofs; };
__device__ __forceinline__ void p0_item_load(const P0Item& it, f32x4 (&v)[8], int lane) {
    const float* wp = it.W + (size_t)(it.k0 + (lane >> 3)) * it.N + it.n0 + 4 * (lane & 7);
#pragma unroll
    for (int i = 0; i < 8; ++i) v[i] = __builtin_nontemporal_load((const GAS f32x4*)(wp + (size_t)(8 * i) * it.N));
    if (it.kscale) {
#pragma unroll
        for (int i = 0; i < 8; ++i) v[i] = v[i] * it.kscale[it.k0 + (lane >> 3) + 8 * i];
    }
}
__device__ __forceinline__ void p0_item_finish(const P0Item& it, const f32x4 (&v)[8], LAS float* scr, int lane) {
#pragma unroll
    for (int i = 0; i < 8; ++i) { LAS float* d = scr + ((lane >> 3) + 8 * i) * 33 + 4 * (lane & 7); d[0] = v[i].x; d[1] = v[i].y; d[2] = v[i].z; d[3] = v[i].w; }
    LDS_WAIT(); asm volatile("" ::: "memory");
    const int c = lane & 7;
#pragma unroll
    for (int j = 0; j < 4; ++j) { const int n = (lane >> 3) + 8 * j; const LAS float* s = scr + (8 * c) * 33 + n;
        v4u o; o.x = pk2(s[0 * 33], s[1 * 33]); o.y = pk2(s[2 * 33], s[3 * 33]); o.z = pk2(s[4 * 33], s[5 * 33]); o.w = pk2(s[6 * 33], s[7 * 33]);
        *(GAS v4u*)(it.WT + (size_t)(it.drow0 + n) * it.ldk + it.kofs + it.k0 + 8 * c) = o; }
    LDS_WAIT(); asm volatile("" ::: "memory");
}
__device__ __forceinline__ P0Item p0_decode(const Args& a, int r) {
    unsigned char* ws = a.ws; P0Item it; it.kofs = 0; it.kscale = nullptr;
    constexpr int I_IN = (D / 64) * (NIN / 32), I_BR = (AW / 64) * (D / 32), I_O = (D / 64) * (D / 32), I_GU = (D / 64) * (FF / 32);
    if (r < I_IN) { const int nblk = NIN / 32, kb = r / nblk, nb = r % nblk, n0 = 32 * nb;
        const int within = n0 & 255; int drow0 = (n0 & ~255) + 128 * ((within >> 5) & 1) + 32 * (within >> 6);
        if (n0 >= 2304) { const int gb = n0 >= 3328 ? 1 : 0, c = n0 - 2304 - 1024 * gb; drow0 = 256 * (9 + (c >> 7)) + 128 * gb + (c & 127); }
        it.W = OPQ(a.in[2]); it.WT = (bf16*)(ws + WS_WIN); it.ldk = D; it.N = NIN; it.k0 = 64 * kb; it.n0 = n0; it.drow0 = drow0; return it; } r -= I_IN;
    if (r < 2 * I_BR) { const int second = r >= I_BR ? 1 : 0; if (second) r -= I_BR; const int nblk = D / 32, kb = r / nblk, nb = r % nblk;
        it.W = second ? OPQ(a.in[11]) : OPQ(a.in[10]); it.WT = (bf16*)(ws + WS_WB); it.ldk = D; it.N = D; it.k0 = 64 * kb; it.n0 = 32 * nb; it.drow0 = 32 * nb; it.kofs = second ? AW : 0; return it; } r -= 2 * I_BR;
    if (r < I_O) { const int nblk = D / 32, kb = r / nblk, nb = r % nblk;
        it.W = OPQ(a.in[12]); it.WT = (bf16*)(ws + WS_WO); it.ldk = D; it.N = D; it.k0 = 64 * kb; it.n0 = 32 * nb; it.drow0 = 32 * nb; return it; } r -= I_O;
    if (r < 2 * I_GU) { const int up = r >= I_GU ? 1 : 0; if (up) r -= I_GU; const int nblk = FF / 32, kb = r / nblk, nb = r % nblk, n0 = 32 * nb;
        it.W = up ? OPQ(a.in[15]) : OPQ(a.in[14]); it.WT = (bf16*)(ws + WS_WGU); it.ldk = D; it.N = FF; it.k0 = 64 * kb; it.n0 = n0; it.drow0 = 256 * (n0 >> 7) + 128 * up + (n0 & 127); if (MK_BF16_RESID) it.kscale = OPQ(a.in[13]); return it; } r -= 2 * I_GU;
    { const int nblk = D / 32, kb = r / nblk, nb = r % nblk;
      it.W = OPQ(a.in[16]); it.WT = (bf16*)(ws + WS_WD); it.ldk = FF; it.N = D; it.k0 = 64 * kb; it.n0 = 32 * nb; it.drow0 = 32 * nb; return it; }
}
__device__ __forceinline__ void p0_prologue(Frame& F, const Args& a, int item_lo, int item_hi, int gw, int NGW, bool rows) {
    LAS float* scr = (LAS float*)(F.lds + RING_OFF + F.wave * 16384);
    constexpr int I_IN = (D / 64) * (NIN / 32), I_BR = (AW / 64) * (D / 32), I_O = (D / 64) * (D / 32), I_GU = (D / 64) * (FF / 32), I_D = (FF / 64) * (D / 32);
    {
        f32x4 vc[8], vn[8];
        int it = gw >= 0 ? item_lo + gw : item_hi;
        P0Item cur = p0_decode(a, it < item_hi ? it : 0);
        if (it < item_hi) p0_item_load(cur, vc, F.lane);
        while (it < item_hi) {
            const int nx = it + NGW; const bool more = nx < item_hi;
            const P0Item nxt = p0_decode(a, more ? nx : 0);
            if (more) p0_item_load(nxt, vn, F.lane);
            p0_item_finish(cur, vc, scr, F.lane);
#pragma unroll
            for (int i = 0; i < 8; ++i) vc[i] = vn[i];
            cur = nxt; it = nx;
        }
    }
    if (!rows) return;
    const float* x = a.in[0]; const float* g = a.in[1]; bf16* XN = (bf16*)(a.ws + WS_XN);
    const GAS f32x4* gr = (const GAS f32x4*)g + F.lane;
    for (int m = gw; m < M; m += 4 * NGW) {
        f32x4 v[4][4];
#pragma unroll
        for (int q = 0; q < 4; ++q) { const GAS f32x4* xr = (const GAS f32x4*)(x + (size_t)(m + q * NGW) * D) + F.lane;
#pragma unroll
            for (int j = 0; j < 4; ++j) v[q][j] = __builtin_nontemporal_load(xr + 64 * j); }
        f32x4 gg[4];
#pragma unroll
        for (int j = 0; j < 4; ++j) gg[j] = gr[64 * j];
#pragma unroll
        for (int q = 0; q < 4; ++q) { float s = 0.f;
#pragma unroll
            for (int j = 0; j < 4; ++j) s += (v[q][j].x * v[q][j].x + v[q][j].y * v[q][j].y) + (v[q][j].z * v[q][j].z + v[q][j].w * v[q][j].w);
            const float rs = 1.0f / sqrtf(wave_sum(s) * (1.f / D) + 1e-6f);
            GAS unsigned long long* o8 = (GAS unsigned long long*)(XN + (size_t)(m + q * NGW) * D) + F.lane;
#pragma unroll
            for (int j = 0; j < 4; ++j) o8[64 * j] = (unsigned long long)pk2(v[q][j].x * rs * gg[j].x, v[q][j].y * rs * gg[j].y) | ((unsigned long long)pk2(v[q][j].z * rs * gg[j].z, v[q][j].w * rs * gg[j].w) << 32); }
    }
}

__global__ void __launch_bounds__(NWAVES * 64, 2) skel_fwd(Args args) {
    extern __shared__ __attribute__((aligned(16))) unsigned char lds[];
    Frame F;
    F.lds = (LAS unsigned char*)lds;
    F.MISC = (volatile LAS unsigned*)(F.lds + MISC_OFF);
    F.tid = threadIdx.x; F.lane = F.tid & 63; F.wave = __builtin_amdgcn_readfirstlane(F.tid >> 6);
    F.G = gridDim.x; { const int bx = blockIdx.x; F.vcu = (F.G % 8 == 0) ? (bx % 8) * (F.G / 8) + bx / 8 : bx; }
    unsigned char* ws = args.ws;
    F.ctl = (gu32*)(ws + WS_CTL);
    for (int u = F.tid; u < (LDS_BYTES - LDSCTL_OFF) / 4; u += NWAVES * 64) ((LAS unsigned*)(F.lds + LDSCTL_OFF))[u] = 0u;
    __syncthreads();
    const int lo = args.ph_lo, hi = args.ph_hi;
    if (F.tid == 0) __hip_atomic_store(F.ctl + CW_XCC + blockIdx.x, xb_xcc_id() + 1u, RLX_AGENT);
#if MK_CODE_PREFETCH
    unsigned long long pc0_; asm volatile("s_getpc_b64 %0" : "=s"(pc0_));
    const char* const code_slice = (const char*)pc0_ + (size_t)(blockIdx.x >> 3) * (MK_CODE_BYTES / 32) + 64 * F.lane;
#define CODE_TOUCH() do { if (F.wave == 0 && 64 * F.lane < MK_CODE_BYTES / 32) { unsigned cw_ = __builtin_nontemporal_load((const unsigned*)code_slice); asm volatile("" :: "v"(cw_)); } } while (0)
#else
#define CODE_TOUCH() do {} while (0)
#endif
#ifdef MK_STAMP_A
    unsigned long long ts_prev = __builtin_amdgcn_s_memrealtime(); const unsigned long long ts0 = ts_prev; unsigned enc_a = 0, enc_b = 0; int ts_n = 0;
#define STAMP() do { const unsigned long long now_ = __builtin_amdgcn_s_memrealtime(); const unsigned d_ = (unsigned)(now_ - ts_prev); if (ts_n == MK_STAMP_A) enc_a = d_; if (ts_n == MK_STAMP_B) enc_b = d_; ts_prev = now_; ++ts_n; } while (0)
#else
#define STAMP() do {} while (0)
#endif
    const bool multi = (hi - lo) > 1;
    XcdBarrier bar; bar.bar = (unsigned*)(F.ctl + CW_BAR); bar.x = 0; bar.st = nullptr;
    if (multi) bar = xcd_barrier_post((unsigned*)(F.ctl + CW_BAR), F.MISC + 8);
#define IN(k) (lo <= (k) && (k) < hi)
#define BOTH(k) (IN(k) && IN((k) + 1))
#define GRID_BAR() do { CODE_TOUCH(); xcd_barrier(bar); } while (0)
    unsigned grp_n = 0;
    bool grp_local = false;
#if MK_GROUP_BAR
#define GROUP_BAR() do { if (grp_local) { ++grp_n; group_barrier(F.ctl + CW_GRP + 64 * (blockIdx.x & 7), grp_n * (unsigned)(F.G >> 3), F.ctl + CW_TMO); } else GRID_BAR(); } while (0)
#else
#define GROUP_BAR() GRID_BAR()
#endif
    bf16* const WIN = (bf16*)(ws + WS_WIN); bf16* const WB = (bf16*)(ws + WS_WB); bf16* const WO = (bf16*)(ws + WS_WO);
    bf16* const WGU = (bf16*)(ws + WS_WGU); bf16* const WD = (bf16*)(ws + WS_WD);
    bf16* const XN = (bf16*)(ws + WS_XN); bf16* const Y = (bf16*)(ws + WS_Y);
    bf16* const QA = (bf16*)(ws + WS_QA); bf16* const KA = (bf16*)(ws + WS_KA); bf16* const VAT = (bf16*)(ws + WS_VAT); bf16* const QB = (bf16*)(ws + WS_QB);
    bf16* const KB = (bf16*)(ws + WS_KB); bf16* const VBT = (bf16*)(ws + WS_VBT); bf16* const GATE = (bf16*)(ws + WS_GATE);
    bf16* const OA = (bf16*)(ws + WS_OA); bf16* const OB = (bf16*)(ws + WS_OB); bf16* const X1B = (bf16*)(ws + WS_X1B); bf16* const U = (bf16*)(ws + WS_U);
    float* const SS = (float*)(ws + WS_SS);

#ifdef MK_TWOPASS
    for (int pass_ = 0; pass_ < 2; ++pass_) { if (pass_) GRID_BAR();
#endif
    constexpr int P0_I_IN = (D / 64) * (NIN / 32), P0_NITEMS = P0_I_IN + 2 * (AW / 64) * (D / 32) + (D / 64) * (D / 32) + 2 * (D / 64) * (FF / 32) + (FF / 64) * (D / 32);
    if (IN(0)) {
#ifdef MK_STAMP_A
        const unsigned p0_t0 = (unsigned)__builtin_amdgcn_s_memrealtime();
#endif
        p0_prologue(F, args, 0, P0_I_IN, F.vcu * NWAVES + F.wave, F.G * NWAVES, true);
#ifdef MK_STAMP_A
        { const unsigned p0_t1 = (unsigned)__builtin_amdgcn_s_memrealtime(); if (MK_STAMP_A == 30) enc_a = p0_t0 - (unsigned)ts0; if (MK_STAMP_A == 31) enc_a = p0_t1 - p0_t0; }
#endif
        if (BOTH(0)) { GRID_BAR();
            if (MK_GROUP_BAR && (F.G & 7) == 0 && F.G <= NWAVES * 64) { int ok = 1;
                if (F.tid < F.G) { const unsigned a_ = __hip_atomic_load(F.ctl + CW_XCC + F.tid, RLX_AGENT), r_ = __hip_atomic_load(F.ctl + CW_XCC + (F.tid & 7), RLX_AGENT); ok = (a_ != 0u && a_ == r_) ? 1 : 0; }
                grp_local = __syncthreads_and(ok) != 0; } }
        STAMP(); }

    if (IN(1)) {
        pg8::Gemm g{XN, WIN, M, NIN, D}; pg8::StaticOrder S; S.init(M, NIN, F.G, (int)blockIdx.x, MK_WGM_P1);
        LAS float* gl = (LAS float*)(F.lds + EPI_TAB_OFF);
        if (F.tid < 256) { const int w = F.tid >> 6, i = F.tid & 63; gl[F.tid] = (w == 0 ? args.in[3] : w == 1 ? args.in[4] : w == 2 ? args.in[6] : args.in[7])[i]; }
        __syncthreads();
        pg8::EpiInProj E{QA, KA, VAT, QB, KB, VBT, GATE, gl, gl + 64, gl + 128, gl + 192, F.lds + EPI_TAB_OFF + 1024 + F.wave * 2304};
        pg8::gemm_phase<pg8::EpiInProj, pg8::StaticOrder, PG8_ALIGN, PG8_SP2>(F.lds + RING_OFF, g, S, E);
#if defined(MK_STAMP_A) && MK_STAMP_A >= 40
        if (F.tid == 0) { if (MK_STAMP_A == 41) enc_a = ((LAS unsigned*)(F.lds + LDSCTL_OFF + 128))[0]; if (MK_STAMP_A == 61) enc_a = ((LAS unsigned*)(F.lds + LDSCTL_OFF + 128))[1]; ((LAS unsigned*)(F.lds + LDSCTL_OFF + 128))[0] = 0u; }
#endif
        {
            const int heavy = (M / 256) * (NIN / 256) - 4 * F.G;
            const int light = F.G - heavy, me = (int)blockIdx.x - heavy;
            if (me >= 0 && me < 8) {
                att::Tensors AT0{nullptr, nullptr, nullptr, nullptr, nullptr, nullptr, nullptr, nullptr, args.in[5], args.in[3], args.in[4], args.in[6], args.in[7], args.in[8], args.in[9]};
                att::build_tables(F.lds + RING_OFF, (float*)(ws + WS_TABS), AT0, me, F.tid, F.wave, F.lane); }
            if (heavy > 0 && light > 0) p0_prologue(F, args, P0_I_IN, P0_NITEMS, me >= 0 ? me * NWAVES + F.wave : -1, light * NWAVES, false);
            else p0_prologue(F, args, P0_I_IN, P0_NITEMS, F.vcu * NWAVES + F.wave, F.G * NWAVES, false);
        }
        if (BOTH(1)) GRID_BAR();
        STAMP();
    }

    if (IN(2)) {
        att::Tensors AT{QA, KA, VAT, QB, KB, VBT, OA, OB, args.in[5], args.in[3], args.in[4], args.in[6], args.in[7], args.in[8], args.in[9]};
#ifdef MK_STAMP_A
        const unsigned p2_t0 = (unsigned)__builtin_amdgcn_s_memrealtime();
#endif
        att::attn_phase(F.lds + RING_OFF, AT, (const float*)(ws + WS_TABS), F.vcu, F.tid, F.wave, F.lane);
#ifdef MK_STAMP_A
        if (F.tid == 0) { const unsigned s0 = ((LAS unsigned*)(F.lds + LDSCTL_OFF + 64))[0], s1 = ((LAS unsigned*)(F.lds + LDSCTL_OFF + 64))[1], e_ = (unsigned)__builtin_amdgcn_s_memrealtime();
            if (MK_STAMP_A == 20) enc_a = s0 - p2_t0; if (MK_STAMP_A == 21) enc_a = s1 - s0; if (MK_STAMP_A == 22) enc_a = e_ - s1; }
#endif
        if (BOTH(2)) GROUP_BAR();
        STAMP();
    }

    if (IN(3)) {
        pg8::Gemm g{OA, WB, M, D, D}; pg8::StaticOrder S; S.init(M, D, F.G, (int)blockIdx.x);
        pg8::EpiBranch E{Y, GATE};
        pg8::gemm_phase<pg8::EpiBranch, pg8::StaticOrder, PG8_ALIGN, PG8_SP2>(F.lds + RING_OFF, g, S, E);
#if defined(MK_STAMP_A) && MK_STAMP_A >= 40
        if (F.tid == 0) { if (MK_STAMP_A == 43) enc_a = ((LAS unsigned*)(F.lds + LDSCTL_OFF + 128))[0]; if (MK_STAMP_A == 63) enc_a = ((LAS unsigned*)(F.lds + LDSCTL_OFF + 128))[1]; ((LAS unsigned*)(F.lds + LDSCTL_OFF + 128))[0] = 0u; }
#endif
        if (BOTH(3)) GROUP_BAR();
        STAMP();
    }

    if (IN(4)) {
        pg8::Gemm g{Y, WO, M, D, D}; pg8::StaticOrder S; S.init(M, D, F.G, (int)blockIdx.x);
        pg8::EpiOut E{args.in[0], MK_BF16_RESID ? nullptr : args.out, X1B, args.in[13], SS, MK_HOOK4(F.vcu)};
        pg8::gemm_phase<pg8::EpiOut, pg8::StaticOrder, false, PG8_SP2>(F.lds + RING_OFF, g, S, E);
#if defined(MK_STAMP_A) && MK_STAMP_A >= 40
        if (F.tid == 0) { if (MK_STAMP_A == 44) enc_a = ((LAS unsigned*)(F.lds + LDSCTL_OFF + 128))[0]; if (MK_STAMP_A == 64) enc_a = ((LAS unsigned*)(F.lds + LDSCTL_OFF + 128))[1]; ((LAS unsigned*)(F.lds + LDSCTL_OFF + 128))[0] = 0u; }
#endif
        if (BOTH(4)) GRID_BAR();
        STAMP();
#ifdef MK_EXTRA_BARS
        for (int xb_ = 0; xb_ < MK_EXTRA_BARS; ++xb_) GRID_BAR();
#endif
    }

    if (IN(5)) {
        pg8::Gemm g{X1B, WGU, M, 2 * FF, D}; pg8::StaticOrder S; S.init(M, 2 * FF, F.G, (int)blockIdx.x, MK_WGM_P5);
        LAS float* rl = (LAS float*)(F.lds + EPI_TAB_OFF);
        { const int rbase = 2048 * ((int)blockIdx.x & 7);
          for (int i = F.tid; i < 2048; i += NWAVES * 64) { const f32x4 q4 = *(const f32x4*)(SS + (size_t)(rbase + i) * 4); rl[i] = __builtin_amdgcn_rsqf(((q4[0] + q4[1]) + (q4[2] + q4[3])) * (1.0f / 1024.0f) + 1e-6f); } }
        __syncthreads();
        pg8::EpiGateUp E{rl, U, FF};
        pg8::gemm_phase<pg8::EpiGateUp, pg8::StaticOrder, PG8_ALIGN, PG8_SP2>(F.lds + RING_OFF, g, S, E);
#if defined(MK_STAMP_A) && MK_STAMP_A >= 40
        if (F.tid == 0) { if (MK_STAMP_A == 45) enc_a = ((LAS unsigned*)(F.lds + LDSCTL_OFF + 128))[0]; if (MK_STAMP_A == 65) enc_a = ((LAS unsigned*)(F.lds + LDSCTL_OFF + 128))[1]; ((LAS unsigned*)(F.lds + LDSCTL_OFF + 128))[0] = 0u; }
#endif
        if (BOTH(5)) GROUP_BAR();
        STAMP();
    }

    if (IN(6)) {
        pg8::Gemm g{U, WD, M, D, FF}; pg8::StaticOrder S; S.init(M, D, F.G, (int)blockIdx.x);
        pg8::EpiDown E{args.out, MK_HOOK6(F.vcu), MK_BF16_RESID ? X1B : nullptr};
        pg8::gemm_phase<pg8::EpiDown, pg8::StaticOrder, PG8_ALIGN, PG8_SP2>(F.lds + RING_OFF, g, S, E);
#if defined(MK_STAMP_A) && MK_STAMP_A >= 40
        if (F.tid == 0) { if (MK_STAMP_A == 46) enc_a = ((LAS unsigned*)(F.lds + LDSCTL_OFF + 128))[0]; if (MK_STAMP_A == 66) enc_a = ((LAS unsigned*)(F.lds + LDSCTL_OFF + 128))[1]; ((LAS unsigned*)(F.lds + LDSCTL_OFF + 128))[0] = 0u; }
#endif
        STAMP();
    }
#ifdef MK_TWOPASS
    }
#endif
#ifdef MK_STAMP_A
    if (MK_STAMP_A == 40) enc_a = ((LAS unsigned*)(F.lds + LDSCTL_OFF + 128))[0];
    if (MK_STAMP_A == 50 && blockIdx.x == 0 && F.tid == 0) {
        unsigned mism = 0; for (int b = 0; b < 256; ++b) mism += (__hip_atomic_load(F.ctl + CW_XCC + b, RLX_AGENT) != __hip_atomic_load(F.ctl + CW_XCC + (b & 7), RLX_AGENT)) ? 1u : 0u;
        unsigned distinct = 0; for (int b = 0; b < 8; ++b) { bool isnew = true; for (int c = 0; c < b; ++c) isnew = isnew && (__hip_atomic_load(F.ctl + CW_XCC + b, RLX_AGENT) != __hip_atomic_load(F.ctl + CW_XCC + c, RLX_AGENT)); distinct += isnew ? 1u : 0u; }
        enc_a = (mism * 100u + distinct) * 100u; }
    if (blockIdx.x == 0 && F.tid == 0) {
        const unsigned long long target = 100000ull + 3ull * (unsigned long long)enc_a + 0ull * enc_b;
        while (__builtin_amdgcn_s_memrealtime() - ts0 < target) __builtin_amdgcn_s_sleep(2);
    }
#endif
#undef IN
#undef BOTH
#undef GRID_BAR
}

extern "C" void kernel_launch(void* const* d_in, const int* in_sizes, int n_in, void* d_out, int out_size, void* d_ws, size_t ws_size, hipStream_t stream) {
    static int grid = 0;
    if (grid == 0) {
        if (n_in != 17 || in_sizes[0] != M * D || out_size != M * D || ws_size < WS_END) { fprintf(stderr, "kernel_launch: unexpected shapes (n_in %d, in0 %d, out %d, ws %zu); nothing launched\n", n_in, n_in > 0 ? in_sizes[0] : -1, out_size, ws_size); grid = -1; return; }
        int dev = 0, cus = 0, per_cu = 0;
        if (hipGetDevice(&dev) != hipSuccess || hipDeviceGetAttribute(&cus, hipDeviceAttributeMultiprocessorCount, dev) != hipSuccess) { grid = -1; return; }
        if (hipFuncSetAttribute((const void*)skel_fwd, hipFuncAttributeMaxDynamicSharedMemorySize, LDS_BYTES) != hipSuccess) { fprintf(stderr, "kernel_launch: hipFuncSetAttribute failed\n"); grid = -1; return; }
        if (hipOccupancyMaxActiveBlocksPerMultiprocessor(&per_cu, (const void*)skel_fwd, NWAVES * 64, LDS_BYTES) != hipSuccess || per_cu < 1) { fprintf(stderr, "kernel_launch: occupancy query says %d workgroups per CU\n", per_cu); per_cu = 1; }
        (void)hipGetLastError();
        grid = cus * per_cu < 256 ? cus * per_cu : 256;
        if (grid != 256) fprintf(stderr, "kernel_launch: grid %d (expected 256)\n", grid);
    }
    if (grid < 0) return;
    (void)hipMemsetAsync((char*)d_ws + WS_CTL, 0, CTL_ZERO_BYTES, stream);
    Args a{};
    for (int i = 0; i < 17; ++i) a.in[i] = (const float*)d_in[i];
    a.out = (float*)d_out; a.ws = (unsigned char*)d_ws;
#ifdef MK_DEBUG_MASK
    using namespace nv;
    unsigned char* ws = (unsigned char*)d_ws; float* out = (float*)d_out;
    Bufs b;
    b.QA = (nv::bf16*)(ws + WS_QA); b.KA = (nv::bf16*)(ws + WS_KA); b.VAT = (nv::bf16*)(ws + WS_VAT); b.QB = (nv::bf16*)(ws + WS_QB); b.KB = (nv::bf16*)(ws + WS_KB); b.VBT = (nv::bf16*)(ws + WS_VBT);
    b.GATE = (nv::bf16*)(ws + WS_GATE); b.OA = (nv::bf16*)(ws + WS_OA); b.OB = (nv::bf16*)(ws + WS_OB); b.Y = (nv::bf16*)(ws + WS_Y); b.X1B = (nv::bf16*)(ws + WS_X1B); b.U = (nv::bf16*)(ws + WS_U);
    b.RS1 = (float*)(ws + WS_RS1); b.SS = (float*)(ws + WS_SS);
    for (int k = 0; k < N_PHASES; ++k) {
        if ((MK_DEBUG_MASK >> k) & 1) { a.ph_lo = k; a.ph_hi = k + 1; hipLaunchKernelGGL(skel_fwd, dim3(grid), dim3(NWAVES * 64), LDS_BYTES, stream, a);
#ifdef DBG_TWICE
            if (k == DBG_TWICE) hipLaunchKernelGGL(skel_fwd, dim3(grid), dim3(NWAVES * 64), LDS_BYTES, stream, a);
#endif
            continue; }
        switch (k) {
        case 1: k_rowscale<<<M_ / 4, 256, 0, stream>>>(a.in[0], b.RS1);
                k_inproj<<<dim3(NIN_ / 64, M_ / 64), 256, 0, stream>>>(a.in[0], a.in[1], b.RS1, a.in[2], a.in[3], a.in[4], a.in[6], a.in[7], b);
                k_gatefix<<<M_ * 1024 / 256, 256, 0, stream>>>(b); break;
        case 2: k_natten<<<M_ * 8 / 256, 256, 0, stream>>>(a.in[5], b); k_swa<<<M_ * 8 / 256, 256, 0, stream>>>(a.in[8], a.in[9], b); break;
        case 3: k_branch<<<dim3(D_ / 64, M_ / 64), 256, 0, stream>>>(a.in[10], a.in[11], b); break;
        case 4: k_outproj<<<dim3(D_ / 64, M_ / 64), 256, 0, stream>>>(a.in[0], a.in[12], a.in[13], out, b); k_rowss<<<M_ / 4, 256, 0, stream>>>(out, b.SS); break;
        case 5: k_gateup<<<dim3(FF_ / 64, M_ / 64), 256, 0, stream>>>(out, a.in[13], a.in[14], a.in[15], b); break;
        case 6: k_down<<<dim3(D_ / 64, M_ / 64), 256, 0, stream>>>(a.in[16], out, b); break;
        default: break;
        }
    }
#else
    if (MK_REPEAT >= 0) {
        a.ph_lo = 0; a.ph_hi = MK_REPEAT + 1; hipLaunchKernelGGL(skel_fwd, dim3(grid), dim3(NWAVES * 64), LDS_BYTES, stream, a);
        (void)hipMemsetAsync((char*)d_ws + WS_CTL, 0, CTL_ZERO_BYTES, stream);
        a.ph_lo = MK_REPEAT; a.ph_hi = N_PHASES; hipLaunchKernelGGL(skel_fwd, dim3(grid), dim3(NWAVES * 64), LDS_BYTES, stream, a);
        return;
    }
    a.ph_lo = 0; a.ph_hi = N_PHASES;
    hipLaunchKernelGGL(skel_fwd, dim3(grid), dim3(NWAVES * 64), LDS_BYTES, stream, a);
#ifdef MK_TWICE
    (void)hipMemsetAsync((char*)d_ws + WS_CTL, 0, CTL_ZERO_BYTES, stream);
    hipLaunchKernelGGL(skel_fwd, dim3(grid), dim3(NWAVES * 64), LDS_BYTES, stream, a);
#endif
#endif
}
```
